# Optimizing an MI355X kernel written in HIP

```python
import math
import jax, jax.numpy as jnp
from jax import lax
import numpy as np

D_MODEL = 1024
BATCH = 8
SEQ = 4096
DEPTH = 1

GRID_W = 64
CTX_LEN = 256
EPS = 1e-6
RG_WIDTH = D_MODEL
RG_BLOCKS = 16
RG_BLOCK = RG_WIDTH // RG_BLOCKS
RG_C = 8.0
CONV_W = 4
CONV_PAD_LEFT = 2
ML_WIDTH = D_MODEL
ML_HEADS = 4
ML_HEAD_DIM = ML_WIDTH // ML_HEADS
ML_QKV_BLOCK = 4
ML_CHUNK = 64
N_IN = 2 * RG_WIDTH + 2 * ML_WIDTH + 2 * D_MODEL
D_FF = int(math.ceil(8 * D_MODEL / 3 / 256)) * 256

kernel_name = "hybrid_rglru_mlstm_dit_block"


def _rmsnorm(x, g):
    xf = x.astype(jnp.float32)
    y = xf * lax.rsqrt(jnp.mean(xf * xf, axis=-1, keepdims=True) + EPS)
    return (y * g.astype(jnp.float32)).astype(x.dtype)


def _modulate(x, shift, scale):
    return x * (1 + scale) + shift


def _conv_centred(x, w, b):
    L = x.shape[1]
    xp = jnp.pad(x, ((0, 0), (CONV_PAD_LEFT, CONV_W - 1 - CONV_PAD_LEFT), (0, 0)))
    y = b
    for j in range(CONV_W):
        y = y + w[j] * xp[:, j:j + L]
    return y


def _block_diag(x, w):
    nb, bi, bo = w.shape
    xs = x.reshape(x.shape[:-1] + (nb, bi))
    return jnp.einsum('...ni,nio->...no', xs, w).reshape(x.shape[:-1] + (nb * bo,))


def _to_col_major(t, rows):
    B, L, C = t.shape
    return t.reshape(B, rows, GRID_W, C).transpose(0, 2, 1, 3).reshape(B, L, C)


def _to_row_major(t, rows):
    B, L, C = t.shape
    return t.reshape(B, GRID_W, rows, C).transpose(0, 2, 1, 3).reshape(B, L, C)


def _rglru_coeffs(xc, wa, ba, wx, bx, lam):
    r = jax.nn.sigmoid(_block_diag(xc, wa) + ba).astype(jnp.float32)
    i = jax.nn.sigmoid(_block_diag(xc, wx) + bx).astype(jnp.float32)
    log_a = -RG_C * jax.nn.softplus(-lam.astype(jnp.float32)) * r
    a = jnp.exp(log_a)
    b = jnp.sqrt(-jnp.expm1(2.0 * log_a)) * (i * xc.astype(jnp.float32))
    return a, b


def _linear_scan(a, b, h0):
    def comb(l, r):
        return l[0] * r[0], r[0] * l[1] + r[1]
    A, H = lax.associative_scan(comb, (a, b), axis=1)
    return H + A * h0[:, None, :]


def _rglru_bidir(xc_lat, xc_ctx, wa, ba, wx, bx, lam):
    outs_l, outs_c = [], []
    for d in range(2):
        rev = d == 1
        seq_c = jnp.flip(xc_ctx, 1) if rev else xc_ctx
        seq_l = jnp.flip(xc_lat, 1) if rev else xc_lat
        a_c, b_c = _rglru_coeffs(seq_c, wa[d], ba[d], wx[d], bx[d], lam[d])
        h_c = _linear_scan(a_c, b_c, jnp.zeros_like(b_c[:, 0]))
        a_l, b_l = _rglru_coeffs(seq_l, wa[d], ba[d], wx[d], bx[d], lam[d])
        h_l = _linear_scan(a_l, b_l, h_c[:, -1])
        if rev:
            h_c, h_l = jnp.flip(h_c, 1), jnp.flip(h_l, 1)
        outs_c.append(h_c)
        outs_l.append(h_l)
    return outs_l[0] + outs_l[1], outs_c[0] + outs_c[1]


def _mlstm_inputs(u, conv_w, conv_b, wq, wk, wv):
    xc = jax.nn.silu(_conv_centred(u, conv_w, conv_b))
    q = _block_diag(xc, wq)
    k = _block_diag(xc, wk) * (ML_HEAD_DIM ** -0.5)
    v = _block_diag(u, wv)
    gin = jnp.concatenate([q, k, v], axis=-1)
    return xc, q, k, v, gin


def _heads(t):
    B, L, _ = t.shape
    return t.astype(jnp.float32).reshape(B, L, ML_HEADS, ML_HEAD_DIM).transpose(0, 2, 1, 3)


def _mlstm_gates(gin, wi, bi, wf, bf):
    log_i = (gin @ wi + bi).astype(jnp.float32)
    log_f = jax.nn.log_sigmoid((gin @ wf + bf).astype(jnp.float32))
    return log_i.transpose(0, 2, 1), log_f.transpose(0, 2, 1)


def _mlstm_chunkwise(q, k, v, log_i, log_f, state):
    B, H, L, dh = q.shape
    nc = L // ML_CHUNK
    to_c = lambda t: jnp.moveaxis(t.reshape((B, H, nc, ML_CHUNK) + t.shape[3:]), 2, 0)
    causal = jnp.tril(jnp.ones((ML_CHUNK, ML_CHUNK), dtype=bool))

    def step(carry, inp):
        C, n, m = carry
        qc, kc, vc, lic, lfc = inp
        bcum = jnp.cumsum(lfc, axis=-1)
        dmat = bcum[..., :, None] - bcum[..., None, :] + lic[..., None, :]
        dmat = jnp.where(causal, dmat, -jnp.inf)
        inter = bcum + m[..., None]
        m_t = jnp.maximum(inter, jnp.max(dmat, axis=-1))
        wmat = jnp.exp(dmat - m_t[..., None])
        s_inter = jnp.exp(inter - m_t)
        s = jnp.einsum('bhtd,bhsd->bhts', qc, kc) * wmat
        num = jnp.einsum('bhts,bhsv->bhtv', s, vc) + s_inter[..., None] * jnp.einsum('bhvk,bhtk->bhtv', C, qc)
        den = jnp.sum(s, axis=-1) + s_inter * jnp.einsum('bhk,bhtk->bht', n, qc)
        h = num / jnp.maximum(jnp.abs(den), jnp.exp(-m_t))[..., None]
        bL = bcum[..., -1]
        g = bL[..., None] - bcum + lic
        m_new = jnp.maximum(bL + m, jnp.max(g, axis=-1))
        decay = jnp.exp(bL + m - m_new)
        ws = jnp.exp(g - m_new[..., None])
        C_new = decay[..., None, None] * C + jnp.einsum('bhs,bhsv,bhsk->bhvk', ws, vc, kc)
        n_new = decay[..., None] * n + jnp.einsum('bhs,bhsk->bhk', ws, kc)
        return (C_new, n_new, m_new), h

    state, hs = lax.scan(step, state, (to_c(q), to_c(k), to_c(v), to_c(log_i), to_c(log_f)))
    h = jnp.moveaxis(hs, 0, 2).reshape(B, H, L, dh)
    return h, state


def _mlstm_bidir(q_l, k_l, v_l, gin_l, q_c, k_c, v_c, gin_c, wi, bi, wf, bf):
    B = q_l.shape[0]
    outs_l, outs_c = [], []
    for d in range(2):
        rev = d == 1
        fl = (lambda t: jnp.flip(t, axis=2)) if rev else (lambda t: t)
        li_c, lf_c = _mlstm_gates(gin_c, wi[d], bi[d], wf[d], bf[d])
        li_l, lf_l = _mlstm_gates(gin_l, wi[d], bi[d], wf[d], bf[d])
        st0 = (jnp.zeros((B, ML_HEADS, ML_HEAD_DIM, ML_HEAD_DIM), jnp.float32),
               jnp.zeros((B, ML_HEADS, ML_HEAD_DIM), jnp.float32),
               jnp.zeros((B, ML_HEADS), jnp.float32))
        h_c, st = _mlstm_chunkwise(fl(q_c), fl(k_c), fl(v_c), fl(li_c), fl(lf_c), st0)
        h_l, _ = _mlstm_chunkwise(fl(q_l), fl(k_l), fl(v_l), fl(li_l), fl(lf_l), st)
        outs_c.append(fl(h_c))
        outs_l.append(fl(h_l))
    return outs_l[0] + outs_l[1], outs_c[0] + outs_c[1]


def _mlstm_out(h, xc, norm_g, skip):
    mu = jnp.mean(h, axis=-1, keepdims=True)
    var = jnp.mean(jnp.square(h - mu), axis=-1, keepdims=True)
    hn = (h - mu) * lax.rsqrt(var + EPS)
    B, H, L, dh = h.shape
    hn = hn.transpose(0, 2, 1, 3).reshape(B, L, H * dh) * norm_g.astype(jnp.float32)
    return (hn + skip.astype(jnp.float32) * xc.astype(jnp.float32)).astype(xc.dtype)


def _merge(y_rg, y_ml, g_rg, g_ml, w_branch_rg, w_branch_ml, w_out):
    mix = jax.nn.sigmoid(g_rg) * (y_rg @ w_branch_rg) + jax.nn.sigmoid(g_ml) * (y_ml @ w_branch_ml)
    return mix @ w_out


def _mixer(u_lat, u_ctx, need_ctx, w_in, rg_conv_w, rg_conv_b, rg_wa, rg_ba, rg_wx, rg_bx, rg_lambda,
           ml_conv_w, ml_conv_b, ml_wq, ml_wk, ml_wv, ml_wi, ml_bi, ml_wf, ml_bf, ml_norm_g, ml_skip,
           w_branch_rg, w_branch_ml, w_out):
    rows = u_lat.shape[1] // GRID_W
    splits = [RG_WIDTH, 2 * RG_WIDTH, 2 * RG_WIDTH + ML_WIDTH, 2 * RG_WIDTH + 2 * ML_WIDTH,
              2 * RG_WIDTH + 2 * ML_WIDTH + D_MODEL]
    rgx_l, rgg_l, mlx_l, mlo_l, gr_l, gm_l = jnp.split(u_lat @ w_in, splits, axis=-1)
    rgx_c, rgg_c, mlx_c, mlo_c, gr_c, gm_c = jnp.split(u_ctx @ w_in, splits, axis=-1)

    xc_l = _conv_centred(rgx_l, rg_conv_w, rg_conv_b)
    xc_c = _conv_centred(rgx_c, rg_conv_w, rg_conv_b)
    h_rg_l, h_rg_c = _rglru_bidir(xc_l, xc_c, rg_wa, rg_ba, rg_wx, rg_bx, rg_lambda)
    y_rg_l = h_rg_l.astype(u_lat.dtype) * jax.nn.gelu(rgg_l)

    xm_l, q_l, k_l, v_l, gin_l = _mlstm_inputs(_to_col_major(mlx_l, rows), ml_conv_w, ml_conv_b, ml_wq, ml_wk, ml_wv)
    xm_c, q_c, k_c, v_c, gin_c = _mlstm_inputs(mlx_c, ml_conv_w, ml_conv_b, ml_wq, ml_wk, ml_wv)
    h_ml_l, h_ml_c = _mlstm_bidir(_heads(q_l), _heads(k_l), _heads(v_l), gin_l,
                                  _heads(q_c), _heads(k_c), _heads(v_c), gin_c,
                                  ml_wi, ml_bi, ml_wf, ml_bf)
    y_ml_l = _to_row_major(_mlstm_out(h_ml_l, xm_l, ml_norm_g, ml_skip), rows) * jax.nn.sigmoid(mlo_l)

    y_lat = _merge(y_rg_l, y_ml_l, gr_l, gm_l, w_branch_rg, w_branch_ml, w_out)
    y_ctx = None
    if need_ctx:
        y_rg_c = h_rg_c.astype(u_ctx.dtype) * jax.nn.gelu(rgg_c)
        y_ml_c = _mlstm_out(h_ml_c, xm_c, ml_norm_g, ml_skip) * jax.nn.sigmoid(mlo_c)
        y_ctx = _merge(y_rg_c, y_ml_c, gr_c, gm_c, w_branch_rg, w_branch_ml, w_out)
    return y_lat, y_ctx


def _swiglu(h, w_ffn_in, w_ffn_out):
    gate, up = jnp.split(h @ w_ffn_in, 2, axis=-1)
    return (jax.nn.silu(gate) * up) @ w_ffn_out


def setup_inputs(seed: int = 0) -> dict:
    key = jax.random.key(seed)
    ks = iter(jax.random.split(key, 48))
    nrm = lambda shape, s: jax.random.normal(next(ks), shape, jnp.float32) * s
    L = DEPTH
    u = jax.random.uniform(next(ks), (L, 2, RG_WIDTH), jnp.float32, minval=0.9, maxval=0.999)
    a0 = u ** (1.0 / RG_C)
    return {
        "x": nrm((BATCH, SEQ, D_MODEL), 1.0),
        "c": nrm((BATCH, D_MODEL), 1.0),
        "ctx": nrm((BATCH, CTX_LEN, D_MODEL), 1.0),
        "c_ctx": nrm((D_MODEL,), 1.0),
        "w_mod": nrm((L, D_MODEL, 6 * D_MODEL), 0.5 * D_MODEL ** -0.5),
        "b_mod": nrm((L, 6 * D_MODEL), 0.02),
        "norm1_g": 1.0 + nrm((L, D_MODEL), 0.02),
        "norm2_g": 1.0 + nrm((L, D_MODEL), 0.02),
        "w_in": nrm((L, D_MODEL, N_IN), D_MODEL ** -0.5),
        "rg_conv_w": nrm((L, CONV_W, RG_WIDTH), CONV_W ** -0.5),
        "rg_conv_b": nrm((L, RG_WIDTH), 0.02),
        "rg_wa": nrm((L, 2, RG_BLOCKS, RG_BLOCK, RG_BLOCK), RG_BLOCK ** -0.5),
        "rg_ba": nrm((L, 2, RG_WIDTH), 0.02),
        "rg_wx": nrm((L, 2, RG_BLOCKS, RG_BLOCK, RG_BLOCK), RG_BLOCK ** -0.5),
        "rg_bx": nrm((L, 2, RG_WIDTH), 0.02),
        "rg_lambda": jnp.log(a0) - jnp.log1p(-a0),
        "ml_conv_w": nrm((L, CONV_W, ML_WIDTH), CONV_W ** -0.5),
        "ml_conv_b": nrm((L, ML_WIDTH), 0.02),
        "ml_wq": nrm((L, ML_WIDTH // ML_QKV_BLOCK, ML_QKV_BLOCK, ML_QKV_BLOCK), ML_QKV_BLOCK ** -0.5),
        "ml_wk": nrm((L, ML_WIDTH // ML_QKV_BLOCK, ML_QKV_BLOCK, ML_QKV_BLOCK), ML_QKV_BLOCK ** -0.5),
        "ml_wv": nrm((L, ML_WIDTH // ML_QKV_BLOCK, ML_QKV_BLOCK, ML_QKV_BLOCK), ML_QKV_BLOCK ** -0.5),
        "ml_wi": nrm((L, 2, 3 * ML_WIDTH, ML_HEADS), (3 * ML_WIDTH) ** -0.5),
        "ml_bi": nrm((L, 2, ML_HEADS), 0.1),
        "ml_wf": nrm((L, 2, 3 * ML_WIDTH, ML_HEADS), (3 * ML_WIDTH) ** -0.5),
        "ml_bf": jnp.linspace(3.0, 6.0, ML_HEADS, dtype=jnp.float32)[None, None, :] + nrm((L, 2, ML_HEADS), 0.1),
        "ml_norm_g": 1.0 + nrm((L, ML_WIDTH), 0.02),
        "ml_skip": 1.0 + nrm((L, ML_WIDTH), 0.02),
        "w_branch_rg": nrm((L, RG_WIDTH, D_MODEL), RG_WIDTH ** -0.5),
        "w_branch_ml": nrm((L, ML_WIDTH, D_MODEL), ML_WIDTH ** -0.5),
        "w_out": nrm((L, D_MODEL, D_MODEL), D_MODEL ** -0.5),
        "w_ffn_in": nrm((L, D_MODEL, 2 * D_FF), D_MODEL ** -0.5),
        "w_ffn_out": nrm((L, D_FF, D_MODEL), D_FF ** -0.5),
        "final_norm_g": 1.0 + nrm((D_MODEL,), 0.02),
    }


def reference(x, c, ctx, c_ctx, w_mod, b_mod, norm1_g, norm2_g, w_in, rg_conv_w, rg_conv_b, rg_wa, rg_ba,
              rg_wx, rg_bx, rg_lambda, ml_conv_w, ml_conv_b, ml_wq, ml_wk, ml_wv, ml_wi, ml_bi, ml_wf, ml_bf,
              ml_norm_g, ml_skip, w_branch_rg, w_branch_ml, w_out, w_ffn_in, w_ffn_out, final_norm_g):
    s_lat = jax.nn.silu(c)
    s_ctx = jax.nn.silu(c_ctx)
    for l in range(DEPTH):
        last = l == DEPTH - 1
        mod_l = (s_lat @ w_mod[l] + b_mod[l])[:, None, :]
        mod_c = s_ctx @ w_mod[l] + b_mod[l]
        sh1, sc1, g1, sh2, sc2, g2 = jnp.split(mod_l, 6, axis=-1)
        csh1, csc1, cg1, csh2, csc2, cg2 = jnp.split(mod_c, 6, axis=-1)

        u_lat = _modulate(_rmsnorm(x, norm1_g[l]), sh1, sc1)
        u_ctx = _modulate(_rmsnorm(ctx, norm1_g[l]), csh1, csc1)
        y_lat, y_ctx = _mixer(u_lat, u_ctx, not last, w_in[l], rg_conv_w[l], rg_conv_b[l], rg_wa[l], rg_ba[l],
                              rg_wx[l], rg_bx[l], rg_lambda[l], ml_conv_w[l], ml_conv_b[l], ml_wq[l], ml_wk[l],
                              ml_wv[l], ml_wi[l], ml_bi[l], ml_wf[l], ml_bf[l], ml_norm_g[l], ml_skip[l],
                              w_branch_rg[l], w_branch_ml[l], w_out[l])
        x = x + g1 * y_lat
        h = _modulate(_rmsnorm(x, norm2_g[l]), sh2, sc2)
        x = x + g2 * _swiglu(h, w_ffn_in[l], w_ffn_out[l])
        if not last:
            ctx = ctx + cg1 * y_ctx
            hc = _modulate(_rmsnorm(ctx, norm2_g[l]), csh2, csc2)
            ctx = ctx + cg2 * _swiglu(hc, w_ffn_in[l], w_ffn_out[l])
    return _rmsnorm(x, final_norm_g)
```

```cpp
#include <hip/hip_runtime.h>
#include <cstdio>
#include <cstdint>

typedef unsigned short bf16_t;
typedef short bf16x8 __attribute__((ext_vector_type(8)));
typedef float f32x4 __attribute__((ext_vector_type(4)));

#define DI __device__ __forceinline__

constexpr int NB = 8, SEQ = 4096, DM = 1024, CTXL = 256, MROWS = NB * SEQ, MCTX = NB * CTXL, DFF = 2816, NIN = 6144, LTOT = SEQ + CTXL;
constexpr float EPS = 1e-6f;

constexpr size_t SZ_ACT = (size_t)MROWS * DM * 2;
constexpr size_t SZ_ACTC = (size_t)MCTX * DM * 2;
constexpr size_t OFF_WINT = 0;
constexpr size_t OFF_WBRG = OFF_WINT + (size_t)NIN * DM * 2;
constexpr size_t OFF_WBML = OFF_WBRG + (size_t)DM * DM * 2;
constexpr size_t OFF_WOUT = OFF_WBML + (size_t)DM * DM * 2;
constexpr size_t OFF_FFNIN = OFF_WOUT + (size_t)DM * DM * 2;
constexpr size_t OFF_FFNOUT = OFF_FFNIN + (size_t)2 * DFF * DM * 2;
constexpr size_t OFF_MODL = OFF_FFNOUT + (size_t)DM * DFF * 2;
constexpr size_t OFF_MODC = OFF_MODL + (size_t)NB * NIN * 4;
constexpr size_t OFF_LOGI = OFF_MODC + (size_t)NIN * 4;
constexpr size_t OFF_LOGF = OFF_LOGI + (size_t)NB * 2 * 4 * LTOT * 4;
constexpr size_t OFF_U = OFF_LOGF + (size_t)NB * 2 * 4 * LTOT * 4;
constexpr size_t OFF_UC = OFF_U + SZ_ACT;
constexpr size_t OFF_RGX = OFF_UC + SZ_ACTC;
constexpr size_t OFF_GGELU = OFF_RGX + SZ_ACT;
constexpr size_t OFF_MLX = OFF_GGELU + SZ_ACT;
constexpr size_t OFF_SMLO = OFF_MLX + SZ_ACT;
constexpr size_t OFF_SGR = OFF_SMLO + SZ_ACT;
constexpr size_t OFF_SGM = OFF_SGR + SZ_ACT;
constexpr size_t OFF_RGXC = OFF_SGM + SZ_ACT;
constexpr size_t OFF_MLXC = OFF_RGXC + SZ_ACTC;
constexpr size_t WS_TOTAL = OFF_MLXC + SZ_ACTC;

struct Params {
    const float *x, *c, *ctx, *c_ctx, *w_mod, *b_mod, *norm1_g, *norm2_g, *w_in, *rg_conv_w, *rg_conv_b, *rg_wa, *rg_ba, *rg_wx, *rg_bx,
        *rg_lambda, *ml_conv_w, *ml_conv_b, *ml_wq, *ml_wk, *ml_wv, *ml_wi, *ml_bi, *ml_wf, *ml_bf, *ml_norm_g, *ml_skip, *w_branch_rg,
        *w_branch_ml, *w_out, *w_ffn_in, *w_ffn_out, *final_norm_g;
    float* out;
    char* ws;
};

DI bf16_t f2bf(float x) { unsigned u = __float_as_uint(x); u += 0x7fffu + ((u >> 16) & 1u); return (bf16_t)(u >> 16); }
DI float bf2f(bf16_t b) { return __uint_as_float(((unsigned)b) << 16); }
DI float sigmoidf_(float x) { return 1.0f / (1.0f + __expf(-x)); }
DI float siluf_(float x) { return x * sigmoidf_(x); }
DI float gelu_tanh(float x) { const float u = 0.7978845608028654f * (x + 0.044715f * x * x * x); return 0.5f * x * (1.0f + tanhf(u)); }
DI float softplusf_(float x) { return fmaxf(x, 0.f) + log1pf(expf(-fabsf(x))); }
DI float wave_sum(float v) {
#pragma unroll
    for (int o = 32; o > 0; o >>= 1) v += __shfl_xor(v, o);
    return v;
}
DI void unpack4(uint2 w, float (&f)[4]) {
    f[0] = __uint_as_float(w.x << 16); f[1] = __uint_as_float(w.x & 0xffff0000u);
    f[2] = __uint_as_float(w.y << 16); f[3] = __uint_as_float(w.y & 0xffff0000u);
}
DI uint2 pack4(float a, float b, float c, float d) {
    uint2 w; w.x = (unsigned)f2bf(a) | ((unsigned)f2bf(b) << 16); w.y = (unsigned)f2bf(c) | ((unsigned)f2bf(d) << 16); return w;
}
DI int lat_tok(int p) { return (p & 63) * 64 + (p >> 6); }

DI void tr_unit(float* tile  , const float* src, int ldsrc, int k0, int n0src, bf16_t* dst, int lddst, int r0dst) {
    const int tid = threadIdx.x;
#pragma unroll
    for (int i = 0; i < 2; ++i) {
        const int k = (tid >> 4) + 32 * i, n4 = (tid & 15) * 4;
        const float4 v = *(const float4*)(src + (size_t)(k0 + k) * ldsrc + n0src + n4);
        tile[k * 65 + n4 + 0] = v.x; tile[k * 65 + n4 + 1] = v.y; tile[k * 65 + n4 + 2] = v.z; tile[k * 65 + n4 + 3] = v.w;
    }
    __syncthreads();
    {
        const int n = tid >> 3, k8 = (tid & 7) * 8;
        float f[8];
#pragma unroll
        for (int j = 0; j < 8; ++j) f[j] = tile[(k8 + j) * 65 + n];
        uint4 w; const uint2 a = pack4(f[0], f[1], f[2], f[3]), b = pack4(f[4], f[5], f[6], f[7]);
        w.x = a.x; w.y = a.y; w.z = b.x; w.w = b.y;
        *(uint4*)(dst + (size_t)(r0dst + n) * lddst + k0 + k8) = w;
    }
    __syncthreads();
}

constexpr int PREP_T0 = 96 * 16;
constexpr int PREP_T1 = PREP_T0 + 3 * 256;
constexpr int PREP_T2 = PREP_T1 + 88 * 16;
constexpr int PREP_T3 = PREP_T2 + 16 * 44;
constexpr int PREP_UNITS = PREP_T3 + 96;

__device__ void phase_prep(const Params& P, char* smem) {
    const int tid = threadIdx.x;
    for (int u = blockIdx.x; u < PREP_UNITS; u += gridDim.x) {
        if (u < PREP_T0) {
            const int nt = u >> 4, kt = u & 15;
            tr_unit((float*)smem, P.w_in, NIN, kt * 64, nt * 64, (bf16_t*)(P.ws + OFF_WINT), DM, nt * 64);
        } else if (u < PREP_T1) {
            const int v = u - PREP_T0, which = v >> 8, w = v & 255, nt = w >> 4, kt = w & 15;
            const float* src = which == 0 ? P.w_branch_rg : which == 1 ? P.w_branch_ml : P.w_out;
            bf16_t* dst = (bf16_t*)(P.ws + (which == 0 ? OFF_WBRG : which == 1 ? OFF_WBML : OFF_WOUT));
            tr_unit((float*)smem, src, DM, kt * 64, nt * 64, dst, DM, nt * 64);
        } else if (u < PREP_T2) {
            const int v = u - PREP_T1, rt = v >> 4, kt = v & 15, R0 = rt * 64, pn = R0 >> 8, rr = R0 & 255;
            const int n0 = rr < 128 ? 128 * pn + rr : DFF + 128 * pn + (rr - 128);
            tr_unit((float*)smem, P.w_ffn_in, 2 * DFF, kt * 64, n0, (bf16_t*)(P.ws + OFF_FFNIN), DM, R0);
        } else if (u < PREP_T3) {
            const int v = u - PREP_T2, nt = v / 44, kt = v % 44;
            tr_unit((float*)smem, P.w_ffn_out, DM, kt * 64, nt * 64, (bf16_t*)(P.ws + OFF_FFNOUT), DFF, nt * 64);
        } else {
            const int j0 = (u - PREP_T3) * 64, wid = tid >> 6, lane = tid & 63;
            float* s = (float*)smem;
            float* red = s + 9 * 1024;
            for (int i = tid; i < 9 * 1024; i += 512) { const int r = i >> 10, k = i & 1023; const float cv = r < 8 ? P.c[r * 1024 + k] : P.c_ctx[k]; s[i] = siluf_(cv); }
            __syncthreads();
            float acc[9];
#pragma unroll
            for (int r = 0; r < 9; ++r) acc[r] = 0.f;
            for (int kk = 0; kk < 128; ++kk) {
                const int k = wid * 128 + kk; const float w = P.w_mod[(size_t)k * NIN + j0 + lane];
#pragma unroll
                for (int r = 0; r < 9; ++r) acc[r] += s[r * 1024 + k] * w;
            }
#pragma unroll
            for (int r = 0; r < 9; ++r) red[(wid * 9 + r) * 64 + lane] = acc[r];
            __syncthreads();
            for (int i = tid; i < 9 * 64; i += 512) {
                const int r = i >> 6, l = i & 63; float t = 0.f;
#pragma unroll
                for (int w = 0; w < 8; ++w) t += red[(w * 9 + r) * 64 + l];
                t += P.b_mod[j0 + l];
                if (r < 8) ((float*)(P.ws + OFF_MODL))[r * NIN + j0 + l] = t; else ((float*)(P.ws + OFF_MODC))[j0 + l] = t;
            }
            __syncthreads();
        }
    }
}

DI void row_modnorm(const float* xr, const float* g, const float* sh, const float* sc, bf16_t* outr, int lane) {
    float4 v[4]; float ss = 0.f;
#pragma unroll
    for (int i = 0; i < 4; ++i) { v[i] = *(const float4*)(xr + i * 256 + lane * 4); ss += v[i].x * v[i].x + v[i].y * v[i].y + v[i].z * v[i].z + v[i].w * v[i].w; }
    ss = wave_sum(ss);
    const float rs = rsqrtf(ss * (1.0f / 1024.0f) + EPS);
#pragma unroll
    for (int i = 0; i < 4; ++i) {
        const int c = i * 256 + lane * 4;
        const float4 gg = *(const float4*)(g + c), s1 = *(const float4*)(sc + c), s0 = *(const float4*)(sh + c);
        const float a = (v[i].x * rs * gg.x) * (1.f + s1.x) + s0.x, b = (v[i].y * rs * gg.y) * (1.f + s1.y) + s0.y;
        const float cc = (v[i].z * rs * gg.z) * (1.f + s1.z) + s0.z, d = (v[i].w * rs * gg.w) * (1.f + s1.w) + s0.w;
        *(uint2*)(outr + c) = pack4(a, b, cc, d);
    }
}
__device__ void phase_u(const Params& P) {
    const int lane = threadIdx.x & 63, gw = (blockIdx.x * blockDim.x + threadIdx.x) >> 6, nw = (gridDim.x * blockDim.x) >> 6;
    const float* modl = (const float*)(P.ws + OFF_MODL); const float* modc = (const float*)(P.ws + OFF_MODC);
    for (int r = gw; r < MROWS + MCTX; r += nw) {
        if (r < MROWS) { const int b = r >> 12; row_modnorm(P.x + (size_t)r * DM, P.norm1_g, modl + b * NIN, modl + b * NIN + 1024, (bf16_t*)(P.ws + OFF_U) + (size_t)r * DM, lane); }
        else { const int rc = r - MROWS; row_modnorm(P.ctx + (size_t)rc * DM, P.norm1_g, modc, modc + 1024, (bf16_t*)(P.ws + OFF_UC) + (size_t)rc * DM, lane); }
    }
}
__device__ void phase_h2(const Params& P) {
    const int lane = threadIdx.x & 63, gw = (blockIdx.x * blockDim.x + threadIdx.x) >> 6, nw = (gridDim.x * blockDim.x) >> 6;
    const float* modl = (const float*)(P.ws + OFF_MODL);
    for (int r = gw; r < MROWS; r += nw) { const int b = r >> 12; row_modnorm(P.out + (size_t)r * DM, P.norm2_g, modl + b * NIN + 3072, modl + b * NIN + 4096, (bf16_t*)(P.ws + OFF_U) + (size_t)r * DM, lane); }
}
__device__ void phase_final(const Params& P) {
    const int lane = threadIdx.x & 63, gw = (blockIdx.x * blockDim.x + threadIdx.x) >> 6, nw = (gridDim.x * blockDim.x) >> 6;
    for (int r = gw; r < MROWS; r += nw) {
        float* xr = P.out + (size_t)r * DM; float4 v[4]; float ss = 0.f;
#pragma unroll
        for (int i = 0; i < 4; ++i) { v[i] = *(const float4*)(xr + i * 256 + lane * 4); ss += v[i].x * v[i].x + v[i].y * v[i].y + v[i].z * v[i].z + v[i].w * v[i].w; }
        ss = wave_sum(ss);
        const float rs = rsqrtf(ss * (1.0f / 1024.0f) + EPS);
#pragma unroll
        for (int i = 0; i < 4; ++i) { const int c = i * 256 + lane * 4; const float4 gg = *(const float4*)(P.final_norm_g + c);
            float4 o; o.x = v[i].x * rs * gg.x; o.y = v[i].y * rs * gg.y; o.z = v[i].z * rs * gg.z; o.w = v[i].w * rs * gg.w; *(float4*)(xr + c) = o; }
    }
}

template <class Epi>
__device__ void gemm_simple(char* smem, const bf16_t* __restrict__ A, const bf16_t* __restrict__ Bt, int M, int N, int K, const Epi& epi) {
    const int tid = threadIdx.x, wid = tid >> 6, lane = tid & 63, wr = wid >> 2, wc = wid & 3, fr = lane & 15, fq = lane >> 4;
    bf16_t* sA = (bf16_t*)smem;
    bf16_t* sB = sA + 128 * 40;
    const int nM = M / 128, nN = N / 256;
    for (int tile = blockIdx.x; tile < nM * nN; tile += gridDim.x) {
        const int pm = tile / nN, pn = tile % nN;
        f32x4 acc[2][4][2];
#pragma unroll
        for (int a = 0; a < 2; ++a)
#pragma unroll
            for (int m = 0; m < 4; ++m)
#pragma unroll
                for (int n = 0; n < 2; ++n) acc[a][m][n] = (f32x4){0.f, 0.f, 0.f, 0.f};
        for (int k0 = 0; k0 < K; k0 += 32) {
            { const int r = tid >> 2, s = tid & 3; *(uint4*)(sA + r * 40 + s * 8) = *(const uint4*)(A + (size_t)(pm * 128 + r) * K + k0 + s * 8); }
#pragma unroll
            for (int i = 0; i < 2; ++i) { const int r = (tid >> 2) + i * 128, s = tid & 3; *(uint4*)(sB + r * 40 + s * 8) = *(const uint4*)(Bt + (size_t)(pn * 256 + r) * K + k0 + s * 8); }
            __syncthreads();
            bf16x8 af[4], bfr[2][2];
#pragma unroll
            for (int m = 0; m < 4; ++m) af[m] = *(const bf16x8*)(sA + (wr * 64 + m * 16 + fr) * 40 + fq * 8);
#pragma unroll
            for (int bj = 0; bj < 2; ++bj)
#pragma unroll
                for (int n = 0; n < 2; ++n) bfr[bj][n] = *(const bf16x8*)(sB + (bj * 128 + wc * 32 + n * 16 + fr) * 40 + fq * 8);
#pragma unroll
            for (int bj = 0; bj < 2; ++bj)
#pragma unroll
                for (int m = 0; m < 4; ++m)
#pragma unroll
                    for (int n = 0; n < 2; ++n) acc[bj][m][n] = __builtin_amdgcn_mfma_f32_16x16x32_bf16(bfr[bj][n], af[m], acc[bj][m][n], 0, 0, 0);
            __syncthreads();
        }
#pragma unroll
        for (int m = 0; m < 4; ++m)
#pragma unroll
            for (int n = 0; n < 2; ++n) epi(pm * 128 + wr * 64 + m * 16 + fr, pn, wc * 32 + n * 16 + fq * 4, acc[0][m][n], acc[1][m][n]);
    }
}

struct EpiInProj {
    bf16_t* base;
    DI void one(int row, int col, f32x4 v) const {
        const int t = col >> 10, cc = col & 1023;
        if (t == 1) { v[0] = gelu_tanh(v[0]); v[1] = gelu_tanh(v[1]); v[2] = gelu_tanh(v[2]); v[3] = gelu_tanh(v[3]); }
        else if (t >= 3) { v[0] = sigmoidf_(v[0]); v[1] = sigmoidf_(v[1]); v[2] = sigmoidf_(v[2]); v[3] = sigmoidf_(v[3]); }
        *(uint2*)(base + (size_t)t * MROWS * DM + (size_t)row * DM + cc) = pack4(v[0], v[1], v[2], v[3]);
    }
    DI void operator()(int row, int pn, int ch, f32x4 a0, f32x4 a1) const { one(row, pn * 256 + ch, a0); one(row, pn * 256 + 128 + ch, a1); }
};
struct EpiPlain {
    bf16_t* dst; int ld;
    DI void operator()(int row, int pn, int ch, f32x4 a0, f32x4 a1) const {
        *(uint2*)(dst + (size_t)row * ld + pn * 256 + ch) = pack4(a0[0], a0[1], a0[2], a0[3]);
        *(uint2*)(dst + (size_t)row * ld + pn * 256 + 128 + ch) = pack4(a1[0], a1[1], a1[2], a1[3]);
    }
};
struct EpiBranch1 {
    const bf16_t* sg; float* T1;
    DI void one(int row, int col, f32x4 v) const { float g[4]; unpack4(*(const uint2*)(sg + (size_t)row * DM + col), g);
        float4 o; o.x = g[0] * v[0]; o.y = g[1] * v[1]; o.z = g[2] * v[2]; o.w = g[3] * v[3]; *(float4*)(T1 + (size_t)row * DM + col) = o; }
    DI void operator()(int row, int pn, int ch, f32x4 a0, f32x4 a1) const { one(row, pn * 256 + ch, a0); one(row, pn * 256 + 128 + ch, a1); }
};
struct EpiBranch2 {
    const bf16_t* sg; const float* T1; bf16_t* mix;
    DI void one(int row, int col, f32x4 v) const { float g[4]; unpack4(*(const uint2*)(sg + (size_t)row * DM + col), g);
        const float4 t = *(const float4*)(T1 + (size_t)row * DM + col);
        *(uint2*)(mix + (size_t)row * DM + col) = pack4(t.x + g[0] * v[0], t.y + g[1] * v[1], t.z + g[2] * v[2], t.w + g[3] * v[3]); }
    DI void operator()(int row, int pn, int ch, f32x4 a0, f32x4 a1) const { one(row, pn * 256 + ch, a0); one(row, pn * 256 + 128 + ch, a1); }
};
struct EpiOutProj {
    const float* x; const float* modl; float* x1;
    DI void one(int row, int col, f32x4 v) const { const int b = row >> 12; const float4 g = *(const float4*)(modl + b * NIN + 2048 + col), xx = *(const float4*)(x + (size_t)row * DM + col);
        float4 o; o.x = xx.x + g.x * v[0]; o.y = xx.y + g.y * v[1]; o.z = xx.z + g.z * v[2]; o.w = xx.w + g.w * v[3]; *(float4*)(x1 + (size_t)row * DM + col) = o; }
    DI void operator()(int row, int pn, int ch, f32x4 a0, f32x4 a1) const { one(row, pn * 256 + ch, a0); one(row, pn * 256 + 128 + ch, a1); }
};
struct EpiFfnIn {
    bf16_t* act;
    DI void operator()(int row, int pn, int ch, f32x4 a0, f32x4 a1) const {
        *(uint2*)(act + (size_t)row * DFF + pn * 128 + ch) = pack4(siluf_(a0[0]) * a1[0], siluf_(a0[1]) * a1[1], siluf_(a0[2]) * a1[2], siluf_(a0[3]) * a1[3]);
    }
};
struct EpiFfnOut {
    float* x12; const float* modl;
    DI void one(int row, int col, f32x4 v) const { const int b = row >> 12; const float4 g = *(const float4*)(modl + b * NIN + 5120 + col); float4 xx = *(const float4*)(x12 + (size_t)row * DM + col);
        xx.x += g.x * v[0]; xx.y += g.y * v[1]; xx.z += g.z * v[2]; xx.w += g.w * v[3]; *(float4*)(x12 + (size_t)row * DM + col) = xx; }
    DI void operator()(int row, int pn, int ch, f32x4 a0, f32x4 a1) const { one(row, pn * 256 + ch, a0); one(row, pn * 256 + 128 + ch, a1); }
};

__device__ void phase_rg_naive(const Params& P) {
    const int tid = threadIdx.x, wid = tid >> 6, lane = tid & 63;
    const bf16_t* rgx = (const bf16_t*)(P.ws + OFF_RGX); const bf16_t* rgxc = (const bf16_t*)(P.ws + OFF_RGXC); const bf16_t* ggelu = (const bf16_t*)(P.ws + OFF_GGELU);
    bf16_t* yrg = (bf16_t*)(P.ws + OFF_U); float* HB = P.out;
    for (int item = blockIdx.x * 8 + wid; item < NB * 16; item += gridDim.x * 8) {
        const int b = item >> 4, n = item & 15, ch = n * 64 + lane;
        float cw[4];
#pragma unroll
        for (int j = 0; j < 4; ++j) cw[j] = P.rg_conv_w[j * DM + ch];
        const float cb = P.rg_conv_b[ch];
        for (int pass = 0; pass < 2; ++pass) {
            const int d = 1 - pass;
            float wa_r[64], wx_r[64];
#pragma unroll
            for (int i = 0; i < 64; ++i) { wa_r[i] = P.rg_wa[((size_t)(d * 16 + n) * 64 + i) * 64 + lane]; wx_r[i] = P.rg_wx[((size_t)(d * 16 + n) * 64 + i) * 64 + lane]; }
            const float ba = P.rg_ba[d * DM + ch], bx = P.rg_bx[d * DM + ch];
            const float cA = -8.0f * softplusf_(-P.rg_lambda[d * DM + ch]);
            float h = 0.f;
            for (int sq = 0; sq < 2; ++sq) {
                const int Ls = sq ? SEQ : CTXL;
                const bf16_t* X = sq ? rgx + (size_t)b * SEQ * DM : rgxc + (size_t)b * CTXL * DM;
                for (int s = 0; s < Ls; ++s) {
                    const int t = d ? Ls - 1 - s : s;
                    float xc = cb;
#pragma unroll
                    for (int j = 0; j < 4; ++j) { const int tt = t + j - 2; if (tt >= 0 && tt < Ls) xc += cw[j] * bf2f(X[(size_t)tt * DM + ch]); }
                    float ra = ba, ri = bx;
#pragma unroll
                    for (int i = 0; i < 64; ++i) { const float xi = __int_as_float(__builtin_amdgcn_readlane(__float_as_int(xc), i)); ra += xi * wa_r[i]; ri += xi * wx_r[i]; }
                    const float r = sigmoidf_(ra), ig = sigmoidf_(ri);
                    const float log_a = cA * r, a = expf(log_a), bb = sqrtf(-expm1f(2.0f * log_a)) * (ig * xc);
                    h = a * h + bb;
                    if (sq) {
                        const size_t o = ((size_t)b * SEQ + t) * DM + ch;
                        if (d) HB[o] = h; else yrg[o] = f2bf((h + HB[o]) * bf2f(ggelu[o]));
                    }
                }
            }
        }
    }
}

DI const bf16_t* ml_row(const Params& P, int b, int sq, int pos) {
    return sq ? (const bf16_t*)(P.ws + OFF_MLX) + ((size_t)b * SEQ + lat_tok(pos)) * DM : (const bf16_t*)(P.ws + OFF_MLXC) + ((size_t)b * CTXL + pos) * DM;
}
__device__ void phase_mlpre(const Params& P, char* smem) {
    float* gin = (float*)smem;
    const int tid = threadIdx.x, slot = tid >> 8, g = tid & 255, wid = tid >> 6, lane = tid & 63;
    float* logi = (float*)(P.ws + OFF_LOGI); float* logf_ = (float*)(P.ws + OFF_LOGF);
    for (int tok0 = blockIdx.x * 2; tok0 < NB * LTOT; tok0 += gridDim.x * 2) {
        {
            const int tok = tok0 + slot, b = tok / LTOT, pidx = tok % LTOT, sq = pidx >= CTXL, pos = sq ? pidx - CTXL : pidx, Ls = sq ? SEQ : CTXL;
            float uu[4][4];
#pragma unroll
            for (int j = 0; j < 4; ++j) { const int pp = pos + j - 2;
                if (pp >= 0 && pp < Ls) unpack4(*(const uint2*)(ml_row(P, b, sq, pp) + 4 * g), uu[j]); else { uu[j][0] = uu[j][1] = uu[j][2] = uu[j][3] = 0.f; } }
            float xm[4];
#pragma unroll
            for (int c = 0; c < 4; ++c) { float a = P.ml_conv_b[4 * g + c];
#pragma unroll
                for (int j = 0; j < 4; ++j) a += P.ml_conv_w[j * DM + 4 * g + c] * uu[j][c];
                xm[c] = siluf_(a); }
#pragma unroll
            for (int o = 0; o < 4; ++o) { float q = 0.f, k = 0.f, v = 0.f;
#pragma unroll
                for (int i = 0; i < 4; ++i) { q += xm[i] * P.ml_wq[(g * 4 + i) * 4 + o]; k += xm[i] * P.ml_wk[(g * 4 + i) * 4 + o]; v += uu[2][i] * P.ml_wv[(g * 4 + i) * 4 + o]; }
                gin[slot * 3072 + 4 * g + o] = q; gin[slot * 3072 + 1024 + 4 * g + o] = k * 0.0625f; gin[slot * 3072 + 2048 + 4 * g + o] = v; }
        }
        __syncthreads();
        {
            const int ws_ = wid >> 2, gate = (wid >> 1) & 1, d = wid & 1;
            const float4* W = (const float4*)((gate ? P.ml_wf : P.ml_wi) + (size_t)d * 3072 * 4);
            float a0 = 0.f, a1 = 0.f, a2 = 0.f, a3 = 0.f;
            for (int j = lane; j < 3072; j += 64) { const float4 w = W[j]; const float gv = gin[ws_ * 3072 + j]; a0 += gv * w.x; a1 += gv * w.y; a2 += gv * w.z; a3 += gv * w.w; }
            a0 = wave_sum(a0); a1 = wave_sum(a1); a2 = wave_sum(a2); a3 = wave_sum(a3);
            if (lane == 0) {
                const int tok = tok0 + ws_, b = tok / LTOT, pidx = tok % LTOT;
                const float* bias = (gate ? P.ml_bf : P.ml_bi) + d * 4; float* dst = (gate ? logf_ : logi);
                const float pre[4] = {a0 + bias[0], a1 + bias[1], a2 + bias[2], a3 + bias[3]};
#pragma unroll
                for (int hh = 0; hh < 4; ++hh) dst[((size_t)(b * 2 + d) * 4 + hh) * LTOT + pidx] = gate ? -softplusf_(-pre[hh]) : pre[hh];
            }
        }
        __syncthreads();
    }
}

__device__ void phase_mlstm_naive(const Params& P, char* smem) {
    float* xm_s = (float*)smem; float* u_s = xm_s + 256; float* q_s = u_s + 256; float* k_s = q_s + 256; float* v_s = k_s + 256;
    const int tid = threadIdx.x, vloc = tid >> 4, kseg = tid & 15;
    const float* logi = (const float*)(P.ws + OFF_LOGI); const float* logf_ = (const float*)(P.ws + OFF_LOGF);
    for (int item = blockIdx.x; item < NB * 4 * 2 * 8; item += gridDim.x) {
        const int vs = item & 7, d = (item >> 3) & 1, hd = (item >> 4) & 3, b = item >> 6;
        bf16_t* Hd = (bf16_t*)(P.ws + (d ? OFF_GGELU : OFF_RGX));
        float C[16], nn[16];
#pragma unroll
        for (int i = 0; i < 16; ++i) { C[i] = 0.f; nn[i] = 0.f; }
        float m = 0.f;
        float cw[4] = {0.f, 0.f, 0.f, 0.f}, cb = 0.f, wq_r[4] = {0.f, 0.f, 0.f, 0.f}, wk_r[4] = {0.f, 0.f, 0.f, 0.f};
        int cg = 0;
        if (tid < 256) { cg = 256 * hd + tid;
#pragma unroll
            for (int j = 0; j < 4; ++j) cw[j] = P.ml_conv_w[j * DM + cg];
            cb = P.ml_conv_b[cg];
#pragma unroll
            for (int i = 0; i < 4; ++i) { wq_r[i] = P.ml_wq[((cg >> 2) * 4 + i) * 4 + (cg & 3)]; wk_r[i] = P.ml_wk[((cg >> 2) * 4 + i) * 4 + (cg & 3)]; }
        } else if (tid < 288) { cg = 256 * hd + 32 * vs + (tid - 256);
#pragma unroll
            for (int i = 0; i < 4; ++i) wq_r[i] = P.ml_wv[((cg >> 2) * 4 + i) * 4 + (cg & 3)];
        }
        for (int sq = 0; sq < 2; ++sq) {
            const int Ls = sq ? SEQ : CTXL, lo = sq ? CTXL : 0;
            for (int s = 0; s < Ls; ++s) {
                const int pos = d ? Ls - 1 - s : s;
                if (tid < 256) {
                    float a = cb, ucur = 0.f;
#pragma unroll
                    for (int j = 0; j < 4; ++j) { const int pp = pos + j - 2; if (pp >= 0 && pp < Ls) { const float uv = bf2f(ml_row(P, b, sq, pp)[cg]); a += cw[j] * uv; if (j == 2) ucur = uv; } }
                    xm_s[tid] = siluf_(a); u_s[tid] = ucur;
                }
                __syncthreads();
                if (tid < 256) { const int g4 = tid & ~3; float q = 0.f, k = 0.f;
#pragma unroll
                    for (int i = 0; i < 4; ++i) { q += xm_s[g4 + i] * wq_r[i]; k += xm_s[g4 + i] * wk_r[i]; }
                    q_s[tid] = q; k_s[tid] = k * 0.0625f;
                } else if (tid < 288) { const int j = tid - 256, g4 = (32 * vs + j) & ~3; float v = 0.f;
#pragma unroll
                    for (int i = 0; i < 4; ++i) v += u_s[g4 + i] * wq_r[i];
                    v_s[j] = v; }
                __syncthreads();
                const size_t gi = ((size_t)(b * 2 + d) * 4 + hd) * LTOT + lo + pos;
                const float li = logi[gi], lf = logf_[gi];
                const float m_new = fmaxf(lf + m, li), fd = expf(lf + m - m_new), iw = expf(li - m_new);
                const float vv = v_s[vloc] * iw; float num = 0.f, den = 0.f;
#pragma unroll
                for (int kk = 0; kk < 16; ++kk) { const float kq = k_s[kseg * 16 + kk], qq = q_s[kseg * 16 + kk];
                    C[kk] = fd * C[kk] + vv * kq; nn[kk] = fd * nn[kk] + iw * kq; num += C[kk] * qq; den += nn[kk] * qq; }
#pragma unroll
                for (int o = 8; o > 0; o >>= 1) { num += __shfl_xor(num, o); den += __shfl_xor(den, o); }
                if (sq && kseg == 0) Hd[((size_t)b * SEQ + pos) * DM + 256 * hd + 32 * vs + vloc] = f2bf(num / fmaxf(fabsf(den), expf(-m_new)));
                m = m_new;
            }
        }
        __syncthreads();
    }
}

__device__ void phase_yml(const Params& P) {
    const int lane = threadIdx.x & 63, gw = (blockIdx.x * blockDim.x + threadIdx.x) >> 6, nw = (gridDim.x * blockDim.x) >> 6;
    const bf16_t* hf = (const bf16_t*)(P.ws + OFF_RGX); const bf16_t* hb = (const bf16_t*)(P.ws + OFF_GGELU); const bf16_t* smlo = (const bf16_t*)(P.ws + OFF_SMLO);
    bf16_t* yml = (bf16_t*)P.out;
    for (int idx = gw; idx < NB * SEQ; idx += nw) {
        const int b = idx >> 12, p = idx & 4095, t = lat_tok(p);
        const size_t hrow = ((size_t)b * SEQ + p) * DM, orow = ((size_t)b * SEQ + t) * DM;
        uint2 outw[4];
#pragma unroll
        for (int i = 0; i < 4; ++i) {
            const int c0 = 256 * i + 4 * lane;
            float a[4], bb[4], hv[4];
            unpack4(*(const uint2*)(hf + hrow + c0), a); unpack4(*(const uint2*)(hb + hrow + c0), bb);
#pragma unroll
            for (int j = 0; j < 4; ++j) hv[j] = a[j] + bb[j];
            const float mu = wave_sum(hv[0] + hv[1] + hv[2] + hv[3]) * (1.0f / 256.0f);
            float dv[4], q = 0.f;
#pragma unroll
            for (int j = 0; j < 4; ++j) { dv[j] = hv[j] - mu; q += dv[j] * dv[j]; }
            const float rs = rsqrtf(wave_sum(q) * (1.0f / 256.0f) + EPS);
            float acc[4];
#pragma unroll
            for (int j = 0; j < 4; ++j) acc[j] = P.ml_conv_b[c0 + j];
#pragma unroll
            for (int jj = 0; jj < 4; ++jj) { const int pp = p + jj - 2; if (pp >= 0 && pp < SEQ) { float uv[4]; unpack4(*(const uint2*)(ml_row(P, b, 1, pp) + c0), uv);
#pragma unroll
                for (int j = 0; j < 4; ++j) acc[j] += P.ml_conv_w[jj * DM + c0 + j] * uv[j]; } }
            float sg[4]; unpack4(*(const uint2*)(smlo + orow + c0), sg);
            float y[4];
#pragma unroll
            for (int j = 0; j < 4; ++j) y[j] = (dv[j] * rs * P.ml_norm_g[c0 + j] + P.ml_skip[c0 + j] * siluf_(acc[j])) * sg[j];
            outw[i] = pack4(y[0], y[1], y[2], y[3]);
        }
#pragma unroll
        for (int i = 0; i < 4; ++i) *(uint2*)(yml + orow + 256 * i + 4 * lane) = outw[i];
    }
}

constexpr int SMEM_BYTES = 65536;
#define STAGE_KERNEL(name, ...) __global__ void __launch_bounds__(512) name(Params P) { __shared__ __attribute__((aligned(16))) char smem[SMEM_BYTES]; (void)smem; __VA_ARGS__ }
STAGE_KERNEL(k_prep, phase_prep(P, smem);)
STAGE_KERNEL(k_u, phase_u(P);)
STAGE_KERNEL(k_inproj, { EpiInProj e{(bf16_t*)(P.ws + OFF_RGX)}; gemm_simple(smem, (const bf16_t*)(P.ws + OFF_U), (const bf16_t*)(P.ws + OFF_WINT), MROWS, NIN, DM, e); })
STAGE_KERNEL(k_inproj_ctx, {
    EpiPlain e0{(bf16_t*)(P.ws + OFF_RGXC), DM}; gemm_simple(smem, (const bf16_t*)(P.ws + OFF_UC), (const bf16_t*)(P.ws + OFF_WINT), MCTX, DM, DM, e0);
    EpiPlain e1{(bf16_t*)(P.ws + OFF_MLXC), DM}; gemm_simple(smem, (const bf16_t*)(P.ws + OFF_UC), (const bf16_t*)(P.ws + OFF_WINT) + (size_t)2048 * DM, MCTX, DM, DM, e1); })
STAGE_KERNEL(k_rg, phase_rg_naive(P);)
STAGE_KERNEL(k_mlpre, phase_mlpre(P, smem);)
STAGE_KERNEL(k_mlstm, phase_mlstm_naive(P, smem);)
STAGE_KERNEL(k_yml, phase_yml(P);)
STAGE_KERNEL(k_branch, {
    EpiBranch1 e0{(const bf16_t*)(P.ws + OFF_SGR), (float*)(P.ws + OFF_RGX)}; gemm_simple(smem, (const bf16_t*)(P.ws + OFF_U), (const bf16_t*)(P.ws + OFF_WBRG), MROWS, DM, DM, e0);
    EpiBranch2 e1{(const bf16_t*)(P.ws + OFF_SGM), (const float*)(P.ws + OFF_RGX), (bf16_t*)(P.ws + OFF_MLX)}; gemm_simple(smem, (const bf16_t*)P.out, (const bf16_t*)(P.ws + OFF_WBML), MROWS, DM, DM, e1); })
STAGE_KERNEL(k_outproj, { EpiOutProj e{P.x, (const float*)(P.ws + OFF_MODL), P.out}; gemm_simple(smem, (const bf16_t*)(P.ws + OFF_MLX), (const bf16_t*)(P.ws + OFF_WOUT), MROWS, DM, DM, e); })
STAGE_KERNEL(k_h2, phase_h2(P);)
STAGE_KERNEL(k_ffnin, { EpiFfnIn e{(bf16_t*)(P.ws + OFF_RGX)}; gemm_simple(smem, (const bf16_t*)(P.ws + OFF_U), (const bf16_t*)(P.ws + OFF_FFNIN), MROWS, 2 * DFF, DM, e); })
STAGE_KERNEL(k_ffnout, { EpiFfnOut e{P.out, (const float*)(P.ws + OFF_MODL)}; gemm_simple(smem, (const bf16_t*)(P.ws + OFF_RGX), (const bf16_t*)(P.ws + OFF_FFNOUT), MROWS, DM, DFF, e); })
STAGE_KERNEL(k_final, phase_final(P);)

extern "C" void kernel_launch(void* const* d_in, const int* in_sizes, int n_in, void* d_out, int out_size, void* d_ws, size_t ws_size, hipStream_t stream) {
    (void)in_sizes; (void)n_in; (void)out_size;
    if (ws_size < WS_TOTAL) { fprintf(stderr, "workspace too small: %zu < %zu\n", ws_size, (size_t)WS_TOTAL); return; }
    Params P{};
    const float** pp = (const float**)&P;
    for (int i = 0; i < 33; ++i) pp[i] = (const float*)d_in[i];
    P.out = (float*)d_out; P.ws = (char*)d_ws;
    const dim3 blk(512);
    k_prep<<<1024, blk, 0, stream>>>(P);
    k_u<<<1024, blk, 0, stream>>>(P);
    k_inproj<<<2048, blk, 0, stream>>>(P);
    k_inproj_ctx<<<64, blk, 0, stream>>>(P);
    k_rg<<<16, blk, 0, stream>>>(P);
    k_mlpre<<<1024, blk, 0, stream>>>(P);
    k_mlstm<<<512, blk, 0, stream>>>(P);
    k_yml<<<1024, blk, 0, stream>>>(P);
    k_branch<<<1024, blk, 0, stream>>>(P);
    k_outproj<<<1024, blk, 0, stream>>>(P);
    k_h2<<<1024, blk, 0, stream>>>(P);
    k_ffnin<<<2048, blk, 0, stream>>>(P);
    k_ffnout<<<1024, blk, 0, stream>>>(P);
    k_final<<<1024, blk, 0, stream>>>(P);
}
```

```cpp
#include <hip/hip_runtime.h>
#include <hip/hip_cooperative_groups.h>
namespace cg = cooperative_groups;
#include <cstdio>
#include <cstdint>

typedef unsigned short bf16_t;
typedef short bf16x8 __attribute__((ext_vector_type(8)));
typedef float f32x4 __attribute__((ext_vector_type(4)));

#define DI __device__ __forceinline__

constexpr int NB = 8, SEQ = 4096, DM = 1024, CTXL = 256, MROWS = NB * SEQ, MCTX = NB * CTXL, DFF = 2816, NIN = 6144, LTOT = SEQ + CTXL;
constexpr float EPS = 1e-6f;

constexpr size_t SZ_ACT = (size_t)MROWS * DM * 2;
constexpr size_t SZ_ACTC = (size_t)MCTX * DM * 2;
constexpr size_t OFF_WINT = 0;
constexpr size_t OFF_WBRG = OFF_WINT + (size_t)NIN * DM * 2;
constexpr size_t OFF_WBML = OFF_WBRG + (size_t)DM * DM * 2;
constexpr size_t OFF_WOUT = OFF_WBML + (size_t)DM * DM * 2;
constexpr size_t OFF_FFNIN = OFF_WOUT + (size_t)DM * DM * 2;
constexpr size_t OFF_FFNOUT = OFF_FFNIN + (size_t)2 * DFF * DM * 2;
constexpr size_t OFF_MODL = OFF_FFNOUT + (size_t)DM * DFF * 2;
constexpr size_t OFF_MODC = OFF_MODL + (size_t)NB * NIN * 4;
constexpr size_t OFF_LOGI = OFF_MODC + (size_t)NIN * 4;
constexpr size_t OFF_LOGF = OFF_LOGI + (size_t)NB * 2 * 4 * LTOT * 4;
constexpr size_t OFF_U = OFF_LOGF + (size_t)NB * 2 * 4 * LTOT * 4;
constexpr size_t OFF_UC = OFF_U + SZ_ACT;
constexpr size_t OFF_RGX = OFF_UC + SZ_ACTC;
constexpr size_t OFF_GGELU = OFF_RGX + SZ_ACT;
constexpr size_t OFF_MLX = OFF_GGELU + SZ_ACT;
constexpr size_t OFF_SMLO = OFF_MLX + SZ_ACT;
constexpr size_t OFF_SGR = OFF_SMLO + SZ_ACT;
constexpr size_t OFF_SGM = OFF_SGR + SZ_ACT;
constexpr size_t OFF_RGXC = OFF_SGM + SZ_ACT;
constexpr size_t OFF_MLXC = OFF_RGXC + SZ_ACTC;
constexpr size_t WS_TOTAL = OFF_MLXC + SZ_ACTC;

struct Params {
    const float *x, *c, *ctx, *c_ctx, *w_mod, *b_mod, *norm1_g, *norm2_g, *w_in, *rg_conv_w, *rg_conv_b, *rg_wa, *rg_ba, *rg_wx, *rg_bx,
        *rg_lambda, *ml_conv_w, *ml_conv_b, *ml_wq, *ml_wk, *ml_wv, *ml_wi, *ml_bi, *ml_wf, *ml_bf, *ml_norm_g, *ml_skip, *w_branch_rg,
        *w_branch_ml, *w_out, *w_ffn_in, *w_ffn_out, *final_norm_g;
    float* out;
    char* ws;
};

DI bf16_t f2bf(float x) { unsigned u = __float_as_uint(x); u += 0x7fffu + ((u >> 16) & 1u); return (bf16_t)(u >> 16); }
DI float bf2f(bf16_t b) { return __uint_as_float(((unsigned)b) << 16); }
DI float sigmoidf_(float x) { return 1.0f / (1.0f + __expf(-x)); }
DI float siluf_(float x) { return x * sigmoidf_(x); }
DI float gelu_tanh(float x) { const float u = 0.7978845608028654f * (x + 0.044715f * x * x * x); return 0.5f * x * (1.0f + tanhf(u)); }
DI float softplusf_(float x) { return fmaxf(x, 0.f) + log1pf(expf(-fabsf(x))); }
DI float wave_sum(float v) {
#pragma unroll
    for (int o = 32; o > 0; o >>= 1) v += __shfl_xor(v, o);
    return v;
}
DI void unpack4(uint2 w, float (&f)[4]) {
    f[0] = __uint_as_float(w.x << 16); f[1] = __uint_as_float(w.x & 0xffff0000u);
    f[2] = __uint_as_float(w.y << 16); f[3] = __uint_as_float(w.y & 0xffff0000u);
}
DI uint2 pack4(float a, float b, float c, float d) {
    uint2 w; w.x = (unsigned)f2bf(a) | ((unsigned)f2bf(b) << 16); w.y = (unsigned)f2bf(c) | ((unsigned)f2bf(d) << 16); return w;
}
DI int lat_tok(int p) { return (p & 63) * 64 + (p >> 6); }

DI void tr_unit(float* tile  , const float* src, int ldsrc, int k0, int n0src, bf16_t* dst, int lddst, int r0dst) {
    const int tid = threadIdx.x;
#pragma unroll
    for (int i = 0; i < 2; ++i) {
        const int k = (tid >> 4) + 32 * i, n4 = (tid & 15) * 4;
        const float4 v = *(const float4*)(src + (size_t)(k0 + k) * ldsrc + n0src + n4);
        tile[k * 65 + n4 + 0] = v.x; tile[k * 65 + n4 + 1] = v.y; tile[k * 65 + n4 + 2] = v.z; tile[k * 65 + n4 + 3] = v.w;
    }
    __syncthreads();
    {
        const int n = tid >> 3, k8 = (tid & 7) * 8;
        float f[8];
#pragma unroll
        for (int j = 0; j < 8; ++j) f[j] = tile[(k8 + j) * 65 + n];
        uint4 w; const uint2 a = pack4(f[0], f[1], f[2], f[3]), b = pack4(f[4], f[5], f[6], f[7]);
        w.x = a.x; w.y = a.y; w.z = b.x; w.w = b.y;
        *(uint4*)(dst + (size_t)(r0dst + n) * lddst + k0 + k8) = w;
    }
    __syncthreads();
}

constexpr int PREP_T0 = 96 * 16;
constexpr int PREP_T1 = PREP_T0 + 3 * 256;
constexpr int PREP_T2 = PREP_T1 + 88 * 16;
constexpr int PREP_T3 = PREP_T2 + 16 * 44;
constexpr int PREP_UNITS = PREP_T3 + 96;

__device__ void phase_prep(const Params& P, char* smem) {
    const int tid = threadIdx.x;
    for (int u = blockIdx.x; u < PREP_UNITS; u += gridDim.x) {
        if (u < PREP_T0) {
            const int nt = u >> 4, kt = u & 15;
            tr_unit((float*)smem, P.w_in, NIN, kt * 64, nt * 64, (bf16_t*)(P.ws + OFF_WINT), DM, nt * 64);
        } else if (u < PREP_T1) {
            const int v = u - PREP_T0, which = v >> 8, w = v & 255, nt = w >> 4, kt = w & 15;
            const float* src = which == 0 ? P.w_branch_rg : which == 1 ? P.w_branch_ml : P.w_out;
            bf16_t* dst = (bf16_t*)(P.ws + (which == 0 ? OFF_WBRG : which == 1 ? OFF_WBML : OFF_WOUT));
            tr_unit((float*)smem, src, DM, kt * 64, nt * 64, dst, DM, nt * 64);
        } else if (u < PREP_T2) {
            const int v = u - PREP_T1, rt = v >> 4, kt = v & 15, R0 = rt * 64, pn = R0 >> 8, rr = R0 & 255;
            const int n0 = rr < 128 ? 128 * pn + rr : DFF + 128 * pn + (rr - 128);
            tr_unit((float*)smem, P.w_ffn_in, 2 * DFF, kt * 64, n0, (bf16_t*)(P.ws + OFF_FFNIN), DM, R0);
        } else if (u < PREP_T3) {
            const int v = u - PREP_T2, nt = v / 44, kt = v % 44;
            tr_unit((float*)smem, P.w_ffn_out, DM, kt * 64, nt * 64, (bf16_t*)(P.ws + OFF_FFNOUT), DFF, nt * 64);
        } else {
            const int j0 = (u - PREP_T3) * 64, wid = tid >> 6, lane = tid & 63;
            float* s = (float*)smem;
            float* red = s + 9 * 1024;
            for (int i = tid; i < 9 * 1024; i += 512) { const int r = i >> 10, k = i & 1023; const float cv = r < 8 ? P.c[r * 1024 + k] : P.c_ctx[k]; s[i] = siluf_(cv); }
            __syncthreads();
            float acc[9];
#pragma unroll
            for (int r = 0; r < 9; ++r) acc[r] = 0.f;
            for (int kk = 0; kk < 128; ++kk) {
                const int k = wid * 128 + kk; const float w = P.w_mod[(size_t)k * NIN + j0 + lane];
#pragma unroll
                for (int r = 0; r < 9; ++r) acc[r] += s[r * 1024 + k] * w;
            }
#pragma unroll
            for (int r = 0; r < 9; ++r) red[(wid * 9 + r) * 64 + lane] = acc[r];
            __syncthreads();
            for (int i = tid; i < 9 * 64; i += 512) {
                const int r = i >> 6, l = i & 63; float t = 0.f;
#pragma unroll
                for (int w = 0; w < 8; ++w) t += red[(w * 9 + r) * 64 + l];
                t += P.b_mod[j0 + l];
                if (r < 8) ((float*)(P.ws + OFF_MODL))[r * NIN + j0 + l] = t; else ((float*)(P.ws + OFF_MODC))[j0 + l] = t;
            }
            __syncthreads();
        }
    }
}

DI void row_modnorm(const float* xr, const float* g, const float* sh, const float* sc, bf16_t* outr, int lane) {
    float4 v[4]; float ss = 0.f;
#pragma unroll
    for (int i = 0; i < 4; ++i) { v[i] = *(const float4*)(xr + i * 256 + lane * 4); ss += v[i].x * v[i].x + v[i].y * v[i].y + v[i].z * v[i].z + v[i].w * v[i].w; }
    ss = wave_sum(ss);
    const float rs = rsqrtf(ss * (1.0f / 1024.0f) + EPS);
#pragma unroll
    for (int i = 0; i < 4; ++i) {
        const int c = i * 256 + lane * 4;
        const float4 gg = *(const float4*)(g + c), s1 = *(const float4*)(sc + c), s0 = *(const float4*)(sh + c);
        const float a = (v[i].x * rs * gg.x) * (1.f + s1.x) + s0.x, b = (v[i].y * rs * gg.y) * (1.f + s1.y) + s0.y;
        const float cc = (v[i].z * rs * gg.z) * (1.f + s1.z) + s0.z, d = (v[i].w * rs * gg.w) * (1.f + s1.w) + s0.w;
        *(uint2*)(outr + c) = pack4(a, b, cc, d);
    }
}
__device__ void phase_u(const Params& P) {
    const int lane = threadIdx.x & 63, gw = (blockIdx.x * blockDim.x + threadIdx.x) >> 6, nw = (gridDim.x * blockDim.x) >> 6;
    const float* modl = (const float*)(P.ws + OFF_MODL); const float* modc = (const float*)(P.ws + OFF_MODC);
    for (int r = gw; r < MROWS + MCTX; r += nw) {
        if (r < MROWS) { const int b = r >> 12; row_modnorm(P.x + (size_t)r * DM, P.norm1_g, modl + b * NIN, modl + b * NIN + 1024, (bf16_t*)(P.ws + OFF_U) + (size_t)r * DM, lane); }
        else { const int rc = r - MROWS; row_modnorm(P.ctx + (size_t)rc * DM, P.norm1_g, modc, modc + 1024, (bf16_t*)(P.ws + OFF_UC) + (size_t)rc * DM, lane); }
    }
}
__device__ void phase_h2(const Params& P) {
    const int lane = threadIdx.x & 63, gw = (blockIdx.x * blockDim.x + threadIdx.x) >> 6, nw = (gridDim.x * blockDim.x) >> 6;
    const float* modl = (const float*)(P.ws + OFF_MODL);
    for (int r = gw; r < MROWS; r += nw) { const int b = r >> 12; row_modnorm(P.out + (size_t)r * DM, P.norm2_g, modl + b * NIN + 3072, modl + b * NIN + 4096, (bf16_t*)(P.ws + OFF_U) + (size_t)r * DM, lane); }
}
__device__ void phase_final(const Params& P) {
    const int lane = threadIdx.x & 63, gw = (blockIdx.x * blockDim.x + threadIdx.x) >> 6, nw = (gridDim.x * blockDim.x) >> 6;
    for (int r = gw; r < MROWS; r += nw) {
        float* xr = P.out + (size_t)r * DM; float4 v[4]; float ss = 0.f;
#pragma unroll
        for (int i = 0; i < 4; ++i) { v[i] = *(const float4*)(xr + i * 256 + lane * 4); ss += v[i].x * v[i].x + v[i].y * v[i].y + v[i].z * v[i].z + v[i].w * v[i].w; }
        ss = wave_sum(ss);
        const float rs = rsqrtf(ss * (1.0f / 1024.0f) + EPS);
#pragma unroll
        for (int i = 0; i < 4; ++i) { const int c = i * 256 + lane * 4; const float4 gg = *(const float4*)(P.final_norm_g + c);
            float4 o; o.x = v[i].x * rs * gg.x; o.y = v[i].y * rs * gg.y; o.z = v[i].z * rs * gg.z; o.w = v[i].w * rs * gg.w; *(float4*)(xr + c) = o; }
    }
}

template <class Epi>
__device__ void gemm_simple(char* smem, const bf16_t* __restrict__ A, const bf16_t* __restrict__ Bt, int M, int N, int K, const Epi& epi) {
    const int tid = threadIdx.x, wid = tid >> 6, lane = tid & 63, wr = wid >> 2, wc = wid & 3, fr = lane & 15, fq = lane >> 4;
    bf16_t* sA = (bf16_t*)smem;
    bf16_t* sB = sA + 128 * 40;
    const int nM = M / 128, nN = N / 256;
    for (int tile = blockIdx.x; tile < nM * nN; tile += gridDim.x) {
        const int pm = tile / nN, pn = tile % nN;
        f32x4 acc[2][4][2];
#pragma unroll
        for (int a = 0; a < 2; ++a)
#pragma unroll
            for (int m = 0; m < 4; ++m)
#pragma unroll
                for (int n = 0; n < 2; ++n) acc[a][m][n] = (f32x4){0.f, 0.f, 0.f, 0.f};
        for (int k0 = 0; k0 < K; k0 += 32) {
            { const int r = tid >> 2, s = tid & 3; *(uint4*)(sA + r * 40 + s * 8) = *(const uint4*)(A + (size_t)(pm * 128 + r) * K + k0 + s * 8); }
#pragma unroll
            for (int i = 0; i < 2; ++i) { const int r = (tid >> 2) + i * 128, s = tid & 3; *(uint4*)(sB + r * 40 + s * 8) = *(const uint4*)(Bt + (size_t)(pn * 256 + r) * K + k0 + s * 8); }
            __syncthreads();
            bf16x8 af[4], bfr[2][2];
#pragma unroll
            for (int m = 0; m < 4; ++m) af[m] = *(const bf16x8*)(sA + (wr * 64 + m * 16 + fr) * 40 + fq * 8);
#pragma unroll
            for (int bj = 0; bj < 2; ++bj)
#pragma unroll
                for (int n = 0; n < 2; ++n) bfr[bj][n] = *(const bf16x8*)(sB + (bj * 128 + wc * 32 + n * 16 + fr) * 40 + fq * 8);
#pragma unroll
            for (int bj = 0; bj < 2; ++bj)
#pragma unroll
                for (int m = 0; m < 4; ++m)
#pragma unroll
                    for (int n = 0; n < 2; ++n) acc[bj][m][n] = __builtin_amdgcn_mfma_f32_16x16x32_bf16(bfr[bj][n], af[m], acc[bj][m][n], 0, 0, 0);
            __syncthreads();
        }
#pragma unroll
        for (int m = 0; m < 4; ++m)
#pragma unroll
            for (int n = 0; n < 2; ++n) epi(pm * 128 + wr * 64 + m * 16 + fr, pn, wc * 32 + n * 16 + fq * 4, acc[0][m][n], acc[1][m][n]);
    }
}

struct EpiInProj {
    bf16_t* base;
    DI void one(int row, int col, f32x4 v) const {
        const int t = col >> 10, cc = col & 1023;
        if (t == 1) { v[0] = gelu_tanh(v[0]); v[1] = gelu_tanh(v[1]); v[2] = gelu_tanh(v[2]); v[3] = gelu_tanh(v[3]); }
        else if (t >= 3) { v[0] = sigmoidf_(v[0]); v[1] = sigmoidf_(v[1]); v[2] = sigmoidf_(v[2]); v[3] = sigmoidf_(v[3]); }
        *(uint2*)(base + (size_t)t * MROWS * DM + (size_t)row * DM + cc) = pack4(v[0], v[1], v[2], v[3]);
    }
    DI void operator()(int row, int pn, int ch, f32x4 a0, f32x4 a1) const { one(row, pn * 256 + ch, a0); one(row, pn * 256 + 128 + ch, a1); }
};
struct EpiPlain {
    bf16_t* dst; int ld;
    DI void operator()(int row, int pn, int ch, f32x4 a0, f32x4 a1) const {
        *(uint2*)(dst + (size_t)row * ld + pn * 256 + ch) = pack4(a0[0], a0[1], a0[2], a0[3]);
        *(uint2*)(dst + (size_t)row * ld + pn * 256 + 128 + ch) = pack4(a1[0], a1[1], a1[2], a1[3]);
    }
};
struct EpiBranch1 {
    const bf16_t* sg; float* T1;
    DI void one(int row, int col, f32x4 v) const { float g[4]; unpack4(*(const uint2*)(sg + (size_t)row * DM + col), g);
        float4 o; o.x = g[0] * v[0]; o.y = g[1] * v[1]; o.z = g[2] * v[2]; o.w = g[3] * v[3]; *(float4*)(T1 + (size_t)row * DM + col) = o; }
    DI void operator()(int row, int pn, int ch, f32x4 a0, f32x4 a1) const { one(row, pn * 256 + ch, a0); one(row, pn * 256 + 128 + ch, a1); }
};
struct EpiBranch2 {
    const bf16_t* sg; const float* T1; bf16_t* mix;
    DI void one(int row, int col, f32x4 v) const { float g[4]; unpack4(*(const uint2*)(sg + (size_t)row * DM + col), g);
        const float4 t = *(const float4*)(T1 + (size_t)row * DM + col);
        *(uint2*)(mix + (size_t)row * DM + col) = pack4(t.x + g[0] * v[0], t.y + g[1] * v[1], t.z + g[2] * v[2], t.w + g[3] * v[3]); }
    DI void operator()(int row, int pn, int ch, f32x4 a0, f32x4 a1) const { one(row, pn * 256 + ch, a0); one(row, pn * 256 + 128 + ch, a1); }
};
struct EpiOutProj {
    const float* x; const float* modl; float* x1;
    DI void one(int row, int col, f32x4 v) const { const int b = row >> 12; const float4 g = *(const float4*)(modl + b * NIN + 2048 + col), xx = *(const float4*)(x + (size_t)row * DM + col);
        float4 o; o.x = xx.x + g.x * v[0]; o.y = xx.y + g.y * v[1]; o.z = xx.z + g.z * v[2]; o.w = xx.w + g.w * v[3]; *(float4*)(x1 + (size_t)row * DM + col) = o; }
    DI void operator()(int row, int pn, int ch, f32x4 a0, f32x4 a1) const { one(row, pn * 256 + ch, a0); one(row, pn * 256 + 128 + ch, a1); }
};
struct EpiFfnIn {
    bf16_t* act;
    DI void operator()(int row, int pn, int ch, f32x4 a0, f32x4 a1) const {
        *(uint2*)(act + (size_t)row * DFF + pn * 128 + ch) = pack4(siluf_(a0[0]) * a1[0], siluf_(a0[1]) * a1[1], siluf_(a0[2]) * a1[2], siluf_(a0[3]) * a1[3]);
    }
};
struct EpiFfnOut {
    float* x12; const float* modl;
    DI void one(int row, int col, f32x4 v) const { const int b = row >> 12; const float4 g = *(const float4*)(modl + b * NIN + 5120 + col); float4 xx = *(const float4*)(x12 + (size_t)row * DM + col);
        xx.x += g.x * v[0]; xx.y += g.y * v[1]; xx.z += g.z * v[2]; xx.w += g.w * v[3]; *(float4*)(x12 + (size_t)row * DM + col) = xx; }
    DI void operator()(int row, int pn, int ch, f32x4 a0, f32x4 a1) const { one(row, pn * 256 + ch, a0); one(row, pn * 256 + 128 + ch, a1); }
};

__device__ void phase_rg_naive(const Params& P) {
    const int tid = threadIdx.x, wid = tid >> 6, lane = tid & 63;
    const bf16_t* rgx = (const bf16_t*)(P.ws + OFF_RGX); const bf16_t* rgxc = (const bf16_t*)(P.ws + OFF_RGXC); const bf16_t* ggelu = (const bf16_t*)(P.ws + OFF_GGELU);
    bf16_t* yrg = (bf16_t*)(P.ws + OFF_U); float* HB = P.out;
    for (int item = wid * gridDim.x + blockIdx.x; item < NB * 16; item += gridDim.x * 8) {
        const int b = item >> 4, n = item & 15, ch = n * 64 + lane;
        float cw[4];
#pragma unroll
        for (int j = 0; j < 4; ++j) cw[j] = P.rg_conv_w[j * DM + ch];
        const float cb = P.rg_conv_b[ch];
        for (int pass = 0; pass < 2; ++pass) {
            const int d = 1 - pass;
            float wa_r[64], wx_r[64];
#pragma unroll
            for (int i = 0; i < 64; ++i) { wa_r[i] = P.rg_wa[((size_t)(d * 16 + n) * 64 + i) * 64 + lane]; wx_r[i] = P.rg_wx[((size_t)(d * 16 + n) * 64 + i) * 64 + lane]; }
            const float ba = P.rg_ba[d * DM + ch], bx = P.rg_bx[d * DM + ch];
            const float cA = -8.0f * softplusf_(-P.rg_lambda[d * DM + ch]);
            float h = 0.f;
            for (int sq = 0; sq < 2; ++sq) {
                const int Ls = sq ? SEQ : CTXL;
                const bf16_t* X = sq ? rgx + (size_t)b * SEQ * DM : rgxc + (size_t)b * CTXL * DM;
                for (int s = 0; s < Ls; ++s) {
                    const int t = d ? Ls - 1 - s : s;
                    float xc = cb;
#pragma unroll
                    for (int j = 0; j < 4; ++j) { const int tt = t + j - 2; if (tt >= 0 && tt < Ls) xc += cw[j] * bf2f(X[(size_t)tt * DM + ch]); }
                    float ra = ba, ri = bx;
#pragma unroll
                    for (int i = 0; i < 64; ++i) { const float xi = __int_as_float(__builtin_amdgcn_readlane(__float_as_int(xc), i)); ra += xi * wa_r[i]; ri += xi * wx_r[i]; }
                    const float r = sigmoidf_(ra), ig = sigmoidf_(ri);
                    const float log_a = cA * r, a = expf(log_a), bb = sqrtf(-expm1f(2.0f * log_a)) * (ig * xc);
                    h = a * h + bb;
                    if (sq) {
                        const size_t o = ((size_t)b * SEQ + t) * DM + ch;
                        if (d) HB[o] = h; else yrg[o] = f2bf((h + HB[o]) * bf2f(ggelu[o]));
                    }
                }
            }
        }
    }
}

DI const bf16_t* ml_row(const Params& P, int b, int sq, int pos) {
    return sq ? (const bf16_t*)(P.ws + OFF_MLX) + ((size_t)b * SEQ + lat_tok(pos)) * DM : (const bf16_t*)(P.ws + OFF_MLXC) + ((size_t)b * CTXL + pos) * DM;
}
__device__ void phase_mlpre(const Params& P, char* smem) {
    float* gin = (float*)smem;
    const int tid = threadIdx.x, slot = tid >> 8, g = tid & 255, wid = tid >> 6, lane = tid & 63;
    float* logi = (float*)(P.ws + OFF_LOGI); float* logf_ = (float*)(P.ws + OFF_LOGF);
    for (int tok0 = blockIdx.x * 2; tok0 < NB * LTOT; tok0 += gridDim.x * 2) {
        {
            const int tok = tok0 + slot, b = tok / LTOT, pidx = tok % LTOT, sq = pidx >= CTXL, pos = sq ? pidx - CTXL : pidx, Ls = sq ? SEQ : CTXL;
            float uu[4][4];
#pragma unroll
            for (int j = 0; j < 4; ++j) { const int pp = pos + j - 2;
                if (pp >= 0 && pp < Ls) unpack4(*(const uint2*)(ml_row(P, b, sq, pp) + 4 * g), uu[j]); else { uu[j][0] = uu[j][1] = uu[j][2] = uu[j][3] = 0.f; } }
            float xm[4];
#pragma unroll
            for (int c = 0; c < 4; ++c) { float a = P.ml_conv_b[4 * g + c];
#pragma unroll
                for (int j = 0; j < 4; ++j) a += P.ml_conv_w[j * DM + 4 * g + c] * uu[j][c];
                xm[c] = siluf_(a); }
#pragma unroll
            for (int o = 0; o < 4; ++o) { float q = 0.f, k = 0.f, v = 0.f;
#pragma unroll
                for (int i = 0; i < 4; ++i) { q += xm[i] * P.ml_wq[(g * 4 + i) * 4 + o]; k += xm[i] * P.ml_wk[(g * 4 + i) * 4 + o]; v += uu[2][i] * P.ml_wv[(g * 4 + i) * 4 + o]; }
                gin[slot * 3072 + 4 * g + o] = q; gin[slot * 3072 + 1024 + 4 * g + o] = k * 0.0625f; gin[slot * 3072 + 2048 + 4 * g + o] = v; }
        }
        __syncthreads();
        {
            const int ws_ = wid >> 2, gate = (wid >> 1) & 1, d = wid & 1;
            const float4* W = (const float4*)((gate ? P.ml_wf : P.ml_wi) + (size_t)d * 3072 * 4);
            float a0 = 0.f, a1 = 0.f, a2 = 0.f, a3 = 0.f;
            for (int j = lane; j < 3072; j += 64) { const float4 w = W[j]; const float gv = gin[ws_ * 3072 + j]; a0 += gv * w.x; a1 += gv * w.y; a2 += gv * w.z; a3 += gv * w.w; }
            a0 = wave_sum(a0); a1 = wave_sum(a1); a2 = wave_sum(a2); a3 = wave_sum(a3);
            if (lane == 0) {
                const int tok = tok0 + ws_, b = tok / LTOT, pidx = tok % LTOT;
                const float* bias = (gate ? P.ml_bf : P.ml_bi) + d * 4; float* dst = (gate ? logf_ : logi);
                const float pre[4] = {a0 + bias[0], a1 + bias[1], a2 + bias[2], a3 + bias[3]};
#pragma unroll
                for (int hh = 0; hh < 4; ++hh) dst[((size_t)(b * 2 + d) * 4 + hh) * LTOT + pidx] = gate ? -softplusf_(-pre[hh]) : pre[hh];
            }
        }
        __syncthreads();
    }
}

__device__ void phase_mlstm_naive(const Params& P, char* smem) {
    float* xm_s = (float*)smem; float* u_s = xm_s + 256; float* q_s = u_s + 256; float* k_s = q_s + 256; float* v_s = k_s + 256;
    const int tid = threadIdx.x, vloc = tid >> 4, kseg = tid & 15;
    const float* logi = (const float*)(P.ws + OFF_LOGI); const float* logf_ = (const float*)(P.ws + OFF_LOGF);
    for (int item = blockIdx.x; item < NB * 4 * 2 * 8; item += gridDim.x) {
        const int vs = item & 7, d = (item >> 3) & 1, hd = (item >> 4) & 3, b = item >> 6;
        bf16_t* Hd = (bf16_t*)(P.ws + (d ? OFF_GGELU : OFF_RGX));
        float C[16], nn[16];
#pragma unroll
        for (int i = 0; i < 16; ++i) { C[i] = 0.f; nn[i] = 0.f; }
        float m = 0.f;
        float cw[4] = {0.f, 0.f, 0.f, 0.f}, cb = 0.f, wq_r[4] = {0.f, 0.f, 0.f, 0.f}, wk_r[4] = {0.f, 0.f, 0.f, 0.f};
        int cg = 0;
        if (tid < 256) { cg = 256 * hd + tid;
#pragma unroll
            for (int j = 0; j < 4; ++j) cw[j] = P.ml_conv_w[j * DM + cg];
            cb = P.ml_conv_b[cg];
#pragma unroll
            for (int i = 0; i < 4; ++i) { wq_r[i] = P.ml_wq[((cg >> 2) * 4 + i) * 4 + (cg & 3)]; wk_r[i] = P.ml_wk[((cg >> 2) * 4 + i) * 4 + (cg & 3)]; }
        } else if (tid < 288) { cg = 256 * hd + 32 * vs + (tid - 256);
#pragma unroll
            for (int i = 0; i < 4; ++i) wq_r[i] = P.ml_wv[((cg >> 2) * 4 + i) * 4 + (cg & 3)];
        }
        for (int sq = 0; sq < 2; ++sq) {
            const int Ls = sq ? SEQ : CTXL, lo = sq ? CTXL : 0;
            for (int s = 0; s < Ls; ++s) {
                const int pos = d ? Ls - 1 - s : s;
                if (tid < 256) {
                    float a = cb, ucur = 0.f;
#pragma unroll
                    for (int j = 0; j < 4; ++j) { const int pp = pos + j - 2; if (pp >= 0 && pp < Ls) { const float uv = bf2f(ml_row(P, b, sq, pp)[cg]); a += cw[j] * uv; if (j == 2) ucur = uv; } }
                    xm_s[tid] = siluf_(a); u_s[tid] = ucur;
                }
                __syncthreads();
                if (tid < 256) { const int g4 = tid & ~3; float q = 0.f, k = 0.f;
#pragma unroll
                    for (int i = 0; i < 4; ++i) { q += xm_s[g4 + i] * wq_r[i]; k += xm_s[g4 + i] * wk_r[i]; }
                    q_s[tid] = q; k_s[tid] = k * 0.0625f;
                } else if (tid < 288) { const int j = tid - 256, g4 = (32 * vs + j) & ~3; float v = 0.f;
#pragma unroll
                    for (int i = 0; i < 4; ++i) v += u_s[g4 + i] * wq_r[i];
                    v_s[j] = v; }
                __syncthreads();
                const size_t gi = ((size_t)(b * 2 + d) * 4 + hd) * LTOT + lo + pos;
                const float li = logi[gi], lf = logf_[gi];
                const float m_new = fmaxf(lf + m, li), fd = expf(lf + m - m_new), iw = expf(li - m_new);
                const float vv = v_s[vloc] * iw; float num = 0.f, den = 0.f;
#pragma unroll
                for (int kk = 0; kk < 16; ++kk) { const float kq = k_s[kseg * 16 + kk], qq = q_s[kseg * 16 + kk];
                    C[kk] = fd * C[kk] + vv * kq; nn[kk] = fd * nn[kk] + iw * kq; num += C[kk] * qq; den += nn[kk] * qq; }
#pragma unroll
                for (int o = 8; o > 0; o >>= 1) { num += __shfl_xor(num, o); den += __shfl_xor(den, o); }
                if (sq && kseg == 0) Hd[((size_t)b * SEQ + pos) * DM + 256 * hd + 32 * vs + vloc] = f2bf(num / fmaxf(fabsf(den), expf(-m_new)));
                m = m_new;
            }
        }
        __syncthreads();
    }
}

__device__ void phase_yml(const Params& P) {
    const int lane = threadIdx.x & 63, gw = (blockIdx.x * blockDim.x + threadIdx.x) >> 6, nw = (gridDim.x * blockDim.x) >> 6;
    const bf16_t* hf = (const bf16_t*)(P.ws + OFF_RGX); const bf16_t* hb = (const bf16_t*)(P.ws + OFF_GGELU); const bf16_t* smlo = (const bf16_t*)(P.ws + OFF_SMLO);
    bf16_t* yml = (bf16_t*)P.out;
    for (int idx = gw; idx < NB * SEQ; idx += nw) {
        const int b = idx >> 12, p = idx & 4095, t = lat_tok(p);
        const size_t hrow = ((size_t)b * SEQ + p) * DM, orow = ((size_t)b * SEQ + t) * DM;
        uint2 outw[4];
#pragma unroll
        for (int i = 0; i < 4; ++i) {
            const int c0 = 256 * i + 4 * lane;
            float a[4], bb[4], hv[4];
            unpack4(*(const uint2*)(hf + hrow + c0), a); unpack4(*(const uint2*)(hb + hrow + c0), bb);
#pragma unroll
            for (int j = 0; j < 4; ++j) hv[j] = a[j] + bb[j];
            const float mu = wave_sum(hv[0] + hv[1] + hv[2] + hv[3]) * (1.0f / 256.0f);
            float dv[4], q = 0.f;
#pragma unroll
            for (int j = 0; j < 4; ++j) { dv[j] = hv[j] - mu; q += dv[j] * dv[j]; }
            const float rs = rsqrtf(wave_sum(q) * (1.0f / 256.0f) + EPS);
            float acc[4];
#pragma unroll
            for (int j = 0; j < 4; ++j) acc[j] = P.ml_conv_b[c0 + j];
#pragma unroll
            for (int jj = 0; jj < 4; ++jj) { const int pp = p + jj - 2; if (pp >= 0 && pp < SEQ) { float uv[4]; unpack4(*(const uint2*)(ml_row(P, b, 1, pp) + c0), uv);
#pragma unroll
                for (int j = 0; j < 4; ++j) acc[j] += P.ml_conv_w[jj * DM + c0 + j] * uv[j]; } }
            float sg[4]; unpack4(*(const uint2*)(smlo + orow + c0), sg);
            float y[4];
#pragma unroll
            for (int j = 0; j < 4; ++j) y[j] = (dv[j] * rs * P.ml_norm_g[c0 + j] + P.ml_skip[c0 + j] * siluf_(acc[j])) * sg[j];
            outw[i] = pack4(y[0], y[1], y[2], y[3]);
        }
#pragma unroll
        for (int i = 0; i < 4; ++i) *(uint2*)(yml + orow + 256 * i + 4 * lane) = outw[i];
    }
}

constexpr int SMEM_BYTES = 65536;
__global__ void __launch_bounds__(512) fwd_mega(Params P) {
    __shared__ __attribute__((aligned(16))) char smem[SMEM_BYTES];
    cg::grid_group grid = cg::this_grid();
    char* ws = P.ws;
    phase_prep(P, smem);
    grid.sync();
    phase_u(P);
    grid.sync();
    { EpiInProj e{(bf16_t*)(ws + OFF_RGX)}; gemm_simple(smem, (const bf16_t*)(ws + OFF_U), (const bf16_t*)(ws + OFF_WINT), MROWS, NIN, DM, e); }
    { EpiPlain e0{(bf16_t*)(ws + OFF_RGXC), DM}; gemm_simple(smem, (const bf16_t*)(ws + OFF_UC), (const bf16_t*)(ws + OFF_WINT), MCTX, DM, DM, e0);
      EpiPlain e1{(bf16_t*)(ws + OFF_MLXC), DM}; gemm_simple(smem, (const bf16_t*)(ws + OFF_UC), (const bf16_t*)(ws + OFF_WINT) + (size_t)2048 * DM, MCTX, DM, DM, e1); }
    grid.sync();
    phase_rg_naive(P);
    phase_mlpre(P, smem);
    grid.sync();
    phase_mlstm_naive(P, smem);
    grid.sync();
    phase_yml(P);
    grid.sync();
    { EpiBranch1 e0{(const bf16_t*)(ws + OFF_SGR), (float*)(ws + OFF_RGX)}; gemm_simple(smem, (const bf16_t*)(ws + OFF_U), (const bf16_t*)(ws + OFF_WBRG), MROWS, DM, DM, e0);
      EpiBranch2 e1{(const bf16_t*)(ws + OFF_SGM), (const float*)(ws + OFF_RGX), (bf16_t*)(ws + OFF_MLX)}; gemm_simple(smem, (const bf16_t*)P.out, (const bf16_t*)(ws + OFF_WBML), MROWS, DM, DM, e1); }
    grid.sync();
    { EpiOutProj e{P.x, (const float*)(ws + OFF_MODL), P.out}; gemm_simple(smem, (const bf16_t*)(ws + OFF_MLX), (const bf16_t*)(ws + OFF_WOUT), MROWS, DM, DM, e); }
    grid.sync();
    phase_h2(P);
    grid.sync();
    { EpiFfnIn e{(bf16_t*)(ws + OFF_RGX)}; gemm_simple(smem, (const bf16_t*)(ws + OFF_U), (const bf16_t*)(ws + OFF_FFNIN), MROWS, 2 * DFF, DM, e); }
    grid.sync();
    { EpiFfnOut e{P.out, (const float*)(ws + OFF_MODL)}; gemm_simple(smem, (const bf16_t*)(ws + OFF_RGX), (const bf16_t*)(ws + OFF_FFNOUT), MROWS, DM, DFF, e); }
    grid.sync();
    phase_final(P);
}

extern "C" void kernel_launch(void* const* d_in, const int* in_sizes, int n_in, void* d_out, int out_size, void* d_ws, size_t ws_size, hipStream_t stream) {
    (void)in_sizes; (void)n_in; (void)out_size;
    if (ws_size < WS_TOTAL) { fprintf(stderr, "workspace too small: %zu < %zu\n", ws_size, (size_t)WS_TOTAL); return; }
    static int grid_blocks = 0;
    if (!grid_blocks) {
        int dev = 0, cus = 0, per_cu = 0;
        (void)hipGetDevice(&dev);
        (void)hipDeviceGetAttribute(&cus, hipDeviceAttributeMultiprocessorCount, dev);
        (void)hipOccupancyMaxActiveBlocksPerMultiprocessor(&per_cu, fwd_mega, 512, 0);
        if (per_cu > 1) per_cu = 1;
        grid_blocks = cus * per_cu;
    }
    Params P{};
    const float** pp = (const float**)&P;
    for (int i = 0; i < 33; ++i) pp[i] = (const float*)d_in[i];
    P.out = (float*)d_out; P.ws = (char*)d_ws;
    void* args[] = {&P};
    hipError_t e = hipLaunchCooperativeKernel((void*)fwd_mega, dim3(grid_blocks), dim3(512), args, 0, stream);
    if (e != hipSuccess) fprintf(stderr, "cooperative launch failed: %s (grid %d)\n", hipGetErrorString(e), grid_blocks);
}
```

```cpp
#ifndef EMU
#include <hip/hip_runtime.h>
#include <hip/hip_cooperative_groups.h>
namespace cg = cooperative_groups;
#include <cstdio>
#include <cstdint>
#define LAS __attribute__((address_space(3)))
#else
#define LAS
#endif

typedef unsigned short bf16_t;
typedef short bf16x8 __attribute__((ext_vector_type(8)));
typedef float f32x4 __attribute__((ext_vector_type(4)));

#define DI __device__ __forceinline__

constexpr int NB = 8, SEQ = 4096, DM = 1024, CTXL = 256, MROWS = NB * SEQ, MCTX = NB * CTXL, DFF = 2816, NIN = 6144, LTOT = SEQ + CTXL;
constexpr float EPS = 1e-6f;

constexpr size_t SZ_ACT = (size_t)MROWS * DM * 2;
constexpr size_t SZ_ACTC = (size_t)MCTX * DM * 2;
constexpr size_t OFF_WINT = 0;
constexpr size_t OFF_WBRG = OFF_WINT + (size_t)NIN * DM * 2;
constexpr size_t OFF_WBML = OFF_WBRG + (size_t)DM * DM * 2;
constexpr size_t OFF_WOUT = OFF_WBML + (size_t)DM * DM * 2;
constexpr size_t OFF_FFNIN = OFF_WOUT + (size_t)DM * DM * 2;
constexpr size_t OFF_FFNOUT = OFF_FFNIN + (size_t)2 * DFF * DM * 2;
constexpr size_t OFF_MODL = OFF_FFNOUT + (size_t)DM * DFF * 2;
constexpr size_t OFF_MODC = OFF_MODL + (size_t)NB * NIN * 4;
constexpr size_t OFF_LOGI = OFF_MODC + (size_t)NIN * 4;
constexpr size_t OFF_LOGF = OFF_LOGI + (size_t)NB * 2 * 4 * LTOT * 4;
constexpr size_t OFF_U = OFF_LOGF + (size_t)NB * 2 * 4 * LTOT * 4;
constexpr size_t OFF_UC = OFF_U + SZ_ACT;
constexpr size_t OFF_RGX = OFF_UC + SZ_ACTC;
constexpr size_t OFF_GGELU = OFF_RGX + SZ_ACT;
constexpr size_t OFF_MLX = OFF_GGELU + SZ_ACT;
constexpr size_t OFF_SMLO = OFF_MLX + SZ_ACT;
constexpr size_t OFF_SGR = OFF_SMLO + SZ_ACT;
constexpr size_t OFF_SGM = OFF_SGR + SZ_ACT;
constexpr size_t OFF_RGXC = OFF_SGM + SZ_ACT;
constexpr size_t OFF_MLXC = OFF_RGXC + SZ_ACTC;
constexpr size_t WS_TOTAL = OFF_MLXC + SZ_ACTC;

struct Params {
    const float *x, *c, *ctx, *c_ctx, *w_mod, *b_mod, *norm1_g, *norm2_g, *w_in, *rg_conv_w, *rg_conv_b, *rg_wa, *rg_ba, *rg_wx, *rg_bx,
        *rg_lambda, *ml_conv_w, *ml_conv_b, *ml_wq, *ml_wk, *ml_wv, *ml_wi, *ml_bi, *ml_wf, *ml_bf, *ml_norm_g, *ml_skip, *w_branch_rg,
        *w_branch_ml, *w_out, *w_ffn_in, *w_ffn_out, *final_norm_g;
    float* out;
    char* ws;
};

DI bf16_t f2bf(float x) { unsigned u = __float_as_uint(x); u += 0x7fffu + ((u >> 16) & 1u); return (bf16_t)(u >> 16); }
DI float bf2f(bf16_t b) { return __uint_as_float(((unsigned)b) << 16); }
#ifndef EMU
#define LAUNDER(p) asm volatile("" : "+v"(p))
#else
#define LAUNDER(p)
#endif
#ifndef EMU
DI float frcp(float x) { return __builtin_amdgcn_rcpf(x); }
#else
DI float frcp(float x) { return 1.0f / x; }
#endif
DI float sigmoidf_(float x) { return frcp(1.0f + __expf(-x)); }
DI float siluf_(float x) { return x * sigmoidf_(x); }
DI float gelu_tanh(float x) { const float u = 0.7978845608028654f * (x + 0.044715f * x * x * x); return 0.5f * x * (1.0f + tanhf(u)); }
DI float softplusf_(float x) { return fmaxf(x, 0.f) + log1pf(expf(-fabsf(x))); }
DI float wave_sum(float v) {
#pragma unroll
    for (int o = 32; o > 0; o >>= 1) v += __shfl_xor(v, o);
    return v;
}
DI void unpack4(uint2 w, float (&f)[4]) {
    f[0] = __uint_as_float(w.x << 16); f[1] = __uint_as_float(w.x & 0xffff0000u);
    f[2] = __uint_as_float(w.y << 16); f[3] = __uint_as_float(w.y & 0xffff0000u);
}
#ifndef EMU
typedef __bf16 bf16x2_n __attribute__((ext_vector_type(2)));
typedef float f32x2_n __attribute__((ext_vector_type(2)));
DI unsigned cvt_pk_bf16(float lo, float hi) { const f32x2_n v = {lo, hi}; return __builtin_bit_cast(unsigned, __builtin_convertvector(v, bf16x2_n)); }
#else
DI unsigned cvt_pk_bf16(float lo, float hi) { return (unsigned)f2bf(lo) | ((unsigned)f2bf(hi) << 16); }
#endif
DI uint2 pack4(float a, float b, float c, float d) { uint2 w; w.x = cvt_pk_bf16(a, b); w.y = cvt_pk_bf16(c, d); return w; }
DI int lat_tok(int p) { return (p & 63) * 64 + (p >> 6); }

DI void tr_unit(float* tile  , const float* src, int ldsrc, int k0, int n0src, bf16_t* dst, int lddst, int r0dst) {
    const int tid = threadIdx.x;
#pragma unroll
    for (int i = 0; i < 2; ++i) {
        const int k = (tid >> 4) + 32 * i, n4 = (tid & 15) * 4;
        const float4 v = *(const float4*)(src + (size_t)(k0 + k) * ldsrc + n0src + n4);
        tile[k * 65 + n4 + 0] = v.x; tile[k * 65 + n4 + 1] = v.y; tile[k * 65 + n4 + 2] = v.z; tile[k * 65 + n4 + 3] = v.w;
    }
    __syncthreads();
    {
        const int n = tid >> 3, k8 = (tid & 7) * 8;
        float f[8];
#pragma unroll
        for (int j = 0; j < 8; ++j) f[j] = tile[(k8 + j) * 65 + n];
        uint4 w; const uint2 a = pack4(f[0], f[1], f[2], f[3]), b = pack4(f[4], f[5], f[6], f[7]);
        w.x = a.x; w.y = a.y; w.z = b.x; w.w = b.y;
        *(uint4*)(dst + (size_t)(r0dst + n) * lddst + k0 + k8) = w;
    }
    __syncthreads();
}

constexpr int PREP_T0 = 96 * 16;
constexpr int PREP_T1 = PREP_T0 + 3 * 256;
constexpr int PREP_T2 = PREP_T1 + 88 * 16;
constexpr int PREP_T3 = PREP_T2 + 16 * 44;
constexpr int PREP_UNITS = PREP_T3 + 96;

__device__ __forceinline__ void phase_prep(const Params& P, char* smem) {
    const int tid = threadIdx.x;
    for (int u = blockIdx.x; u < PREP_UNITS; u += gridDim.x) {
        if (u < PREP_T0) {
            const int nt = u >> 4, kt = u & 15;
            tr_unit((float*)smem, P.w_in, NIN, kt * 64, nt * 64, (bf16_t*)(P.ws + OFF_WINT), DM, nt * 64);
        } else if (u < PREP_T1) {
            const int v = u - PREP_T0, which = v >> 8, w = v & 255, nt = w >> 4, kt = w & 15;
            const float* src = which == 0 ? P.w_branch_rg : which == 1 ? P.w_branch_ml : P.w_out;
            bf16_t* dst = (bf16_t*)(P.ws + (which == 0 ? OFF_WBRG : which == 1 ? OFF_WBML : OFF_WOUT));
            tr_unit((float*)smem, src, DM, kt * 64, nt * 64, dst, DM, nt * 64);
        } else if (u < PREP_T2) {
            const int v = u - PREP_T1, rt = v >> 4, kt = v & 15, R0 = rt * 64, pn = R0 >> 8, rr = R0 & 255;
            const int n0 = rr < 128 ? 128 * pn + rr : DFF + 128 * pn + (rr - 128);
            tr_unit((float*)smem, P.w_ffn_in, 2 * DFF, kt * 64, n0, (bf16_t*)(P.ws + OFF_FFNIN), DM, R0);
        } else if (u < PREP_T3) {
            const int v = u - PREP_T2, nt = v / 44, kt = v % 44;
            tr_unit((float*)smem, P.w_ffn_out, DM, kt * 64, nt * 64, (bf16_t*)(P.ws + OFF_FFNOUT), DFF, nt * 64);
        } else {
            const int j0 = (u - PREP_T3) * 64, wid = tid >> 6, lane = tid & 63;
            float* s = (float*)smem;
            float* red = s + 9 * 1024;
            for (int i = tid; i < 9 * 1024; i += 512) { const int r = i >> 10, k = i & 1023; const float cv = r < 8 ? P.c[r * 1024 + k] : P.c_ctx[k]; s[i] = siluf_(cv); }
            __syncthreads();
            float acc[9];
#pragma unroll
            for (int r = 0; r < 9; ++r) acc[r] = 0.f;
            for (int kk = 0; kk < 128; ++kk) {
                const int k = wid * 128 + kk; const float w = P.w_mod[(size_t)k * NIN + j0 + lane];
#pragma unroll
                for (int r = 0; r < 9; ++r) acc[r] += s[r * 1024 + k] * w;
            }
#pragma unroll
            for (int r = 0; r < 9; ++r) red[(wid * 9 + r) * 64 + lane] = acc[r];
            __syncthreads();
            for (int i = tid; i < 9 * 64; i += 512) {
                const int r = i >> 6, l = i & 63; float t = 0.f;
#pragma unroll
                for (int w = 0; w < 8; ++w) t += red[(w * 9 + r) * 64 + l];
                t += P.b_mod[j0 + l];
                if (r < 8) ((float*)(P.ws + OFF_MODL))[r * NIN + j0 + l] = t; else ((float*)(P.ws + OFF_MODC))[j0 + l] = t;
            }
            __syncthreads();
        }
    }
}

DI void row_modnorm(const float* xr, const float* g, const float* sh, const float* sc, bf16_t* outr, int lane) {
    float4 v[4]; float ss = 0.f;
#pragma unroll
    for (int i = 0; i < 4; ++i) { v[i] = *(const float4*)(xr + i * 256 + lane * 4); ss += v[i].x * v[i].x + v[i].y * v[i].y + v[i].z * v[i].z + v[i].w * v[i].w; }
    ss = wave_sum(ss);
    const float rs = rsqrtf(ss * (1.0f / 1024.0f) + EPS);
#pragma unroll
    for (int i = 0; i < 4; ++i) {
        const int c = i * 256 + lane * 4;
        const float4 gg = *(const float4*)(g + c), s1 = *(const float4*)(sc + c), s0 = *(const float4*)(sh + c);
        const float a = (v[i].x * rs * gg.x) * (1.f + s1.x) + s0.x, b = (v[i].y * rs * gg.y) * (1.f + s1.y) + s0.y;
        const float cc = (v[i].z * rs * gg.z) * (1.f + s1.z) + s0.z, d = (v[i].w * rs * gg.w) * (1.f + s1.w) + s0.w;
        *(uint2*)(outr + c) = pack4(a, b, cc, d);
    }
}
__device__ __forceinline__ void phase_u(const Params& P) {
    const int lane = threadIdx.x & 63, gw = (blockIdx.x * blockDim.x + threadIdx.x) >> 6, nw = (gridDim.x * blockDim.x) >> 6;
    const float* modl = (const float*)(P.ws + OFF_MODL); const float* modc = (const float*)(P.ws + OFF_MODC);
    for (int r = gw; r < MROWS + MCTX; r += nw) {
        if (r < MROWS) { const int b = r >> 12; row_modnorm(P.x + (size_t)r * DM, P.norm1_g, modl + b * NIN, modl + b * NIN + 1024, (bf16_t*)(P.ws + OFF_U) + (size_t)r * DM, lane); }
        else { const int rc = r - MROWS; row_modnorm(P.ctx + (size_t)rc * DM, P.norm1_g, modc, modc + 1024, (bf16_t*)(P.ws + OFF_UC) + (size_t)rc * DM, lane); }
    }
}
__device__ __forceinline__ void phase_h2(const Params& P) {
    const int lane = threadIdx.x & 63, gw = (blockIdx.x * blockDim.x + threadIdx.x) >> 6, nw = (gridDim.x * blockDim.x) >> 6;
    const float* modl = (const float*)(P.ws + OFF_MODL);
    for (int r = gw; r < MROWS; r += nw) { const int b = r >> 12; row_modnorm(P.out + (size_t)r * DM, P.norm2_g, modl + b * NIN + 3072, modl + b * NIN + 4096, (bf16_t*)(P.ws + OFF_U) + (size_t)r * DM, lane); }
}
__device__ __forceinline__ void phase_final(const Params& P) {
    const int lane = threadIdx.x & 63, gw = (blockIdx.x * blockDim.x + threadIdx.x) >> 6, nw = (gridDim.x * blockDim.x) >> 6;
    for (int r = gw; r < MROWS; r += nw) {
        float* xr = P.out + (size_t)r * DM; float4 v[4]; float ss = 0.f;
#pragma unroll
        for (int i = 0; i < 4; ++i) { v[i] = *(const float4*)(xr + i * 256 + lane * 4); ss += v[i].x * v[i].x + v[i].y * v[i].y + v[i].z * v[i].z + v[i].w * v[i].w; }
        ss = wave_sum(ss);
        const float rs = rsqrtf(ss * (1.0f / 1024.0f) + EPS);
#pragma unroll
        for (int i = 0; i < 4; ++i) { const int c = i * 256 + lane * 4; const float4 gg = *(const float4*)(P.final_norm_g + c);
            float4 o; o.x = v[i].x * rs * gg.x; o.y = v[i].y * rs * gg.y; o.z = v[i].z * rs * gg.z; o.w = v[i].w * rs * gg.w; *(float4*)(xr + c) = o; }
    }
}

#ifndef EMU
constexpr int G_BK = 64, G_HALF = 128, G_HTB = G_HALF * G_BK * 2, GEMM_LDS = 8 * G_HTB;
DI int lds_byte(int r, int c) { const int st = (r >> 4) * 2 + (c >> 5), rr = r & 15, cc = c & 31, ob = rr * 64 + cc * 2; return st * 1024 + (ob ^ (((ob >> 9) & 1) << 5)); }
DI void stage_rc(int b, int& R, int& C) { const int st = b / 1024, sb = b % 1024, swz = sb ^ (((sb >> 9) & 1) << 5); R = (st >> 1) * 16 + swz / 64; C = (st & 1) * 32 + (swz % 64) / 2; }
struct Unit { const char* A; const char* B; int pm, pn, kind; };
DI void static_order(int L, int nM, int nN, int& pm, int& pn) {
    const int q = (nM * nN) >> 3, wgid = (L & 7) * q + (L >> 3), nig = 8 * nN, gid = wgid / nig, w = wgid % nig;
    pm = gid * 8 + (w & 7); pn = w >> 3;
}
typedef f32x4 Acc[2][2][4][2];

template <class Sched, class Epi>
__device__ __forceinline__ void gemm8(LAS unsigned char* lds, const int K, const Sched& S, const Epi& E) {
    const int tid = threadIdx.x, wid = __builtin_amdgcn_readfirstlane(tid >> 6), lane = tid & 63, wr = wid >> 2, wc = wid & 3, fr = lane & 15, fq = lane >> 4;
    const int nt = K / G_BK;
    unsigned voff[2];
#pragma unroll
    for (int i = 0; i < 2; ++i) { int R, C; stage_rc(tid * 16 + i * 8192, R, C); voff[i] = (unsigned)(R * K + C) * 2u; }
    const size_t kstep = (size_t)(G_BK * 2), hstep = (size_t)G_HALF * K * 2;
    const unsigned ldsw = (unsigned)wid * 1024u;
    const int aoff = lds_byte(wr * 64 + fr, fq * 8), boff = lds_byte(wc * 32 + fr, fq * 8);
#define G_SA(b, h) (((b) * 2 + (h)) * G_HTB)
#define G_SB(b, h) ((4 + (b) * 2 + (h)) * G_HTB)
#define G_STAGE(bufoff, gbase) do { _Pragma("unroll") for (int _i = 0; _i < 2; ++_i) \
        __builtin_amdgcn_global_load_lds((const unsigned*)((const char*)(gbase) + voff[_i]), (LAS unsigned*)(lds + (bufoff) + ldsw + _i * 8192), 16, 0, 0); } while (0)
#define G_LDA(dst, b, h) do { _Pragma("unroll") for (int m = 0; m < 4; ++m) _Pragma("unroll") for (int k = 0; k < 2; ++k) dst[m][k] = *(const LAS bf16x8*)(lds + G_SA(b, h) + aoff + m * 2048 + k * 1024); } while (0)
#define G_LDB(dst, b, h) do { _Pragma("unroll") for (int n = 0; n < 2; ++n) _Pragma("unroll") for (int k = 0; k < 2; ++k) dst[n][k] = *(const LAS bf16x8*)(lds + G_SB(b, h) + boff + n * 2048 + k * 1024); } while (0)
#define G_MMA(ai, bj, At, Bt) do { __builtin_amdgcn_s_setprio(1); _Pragma("unroll") for (int m = 0; m < 4; ++m) _Pragma("unroll") for (int n = 0; n < 2; ++n) _Pragma("unroll") for (int k = 0; k < 2; ++k) \
        acc[ai][bj][m][n] = __builtin_amdgcn_mfma_f32_16x16x32_bf16(Bt[n][k], At[m][k], acc[ai][bj][m][n], 0, 0, 0); __builtin_amdgcn_s_setprio(0); } while (0)
#define G_WAIT_V(n) asm volatile("s_waitcnt vmcnt(" #n ")" ::: "memory")
#define G_WAIT_L(n) asm volatile("s_waitcnt lgkmcnt(" #n ")" ::: "memory")
#define G_BAR __builtin_amdgcn_s_barrier()
#define G_SCHED __builtin_amdgcn_sched_barrier(0)
#define G_ZERO() do { _Pragma("unroll") for (int a = 0; a < 2; ++a) _Pragma("unroll") for (int b = 0; b < 2; ++b) _Pragma("unroll") for (int m = 0; m < 4; ++m) _Pragma("unroll") for (int n = 0; n < 2; ++n) acc[a][b][m][n] = (f32x4){0.f, 0.f, 0.f, 0.f}; } while (0)
    Unit cur, nxt; int ui = 0;
    if (!S.next(0, cur)) return;
    Acc acc;
    G_ZERO();
    bf16x8 At[4][2], B0[2][2], B1[2][2];
    const char* cA = cur.A; const char* cB = cur.B;
    G_STAGE(G_SB(0, 0), cB); G_STAGE(G_SA(0, 0), cA); G_STAGE(G_SB(0, 1), cB + hstep); G_STAGE(G_SA(0, 1), cA + hstep);
    if (wr == 1) G_BAR;
    G_WAIT_V(4); G_BAR;
    G_STAGE(G_SB(1, 0), cB + kstep); G_STAGE(G_SA(1, 0), cA + kstep); G_STAGE(G_SB(1, 1), cB + hstep + kstep);
    G_WAIT_V(6); G_BAR;
    for (;;) {
        const bool has_next = S.next(ui + 1, nxt);
        const char* nA = has_next ? nxt.A : cA; const char* nB = has_next ? nxt.B : cB;
        for (int t = 0; t < nt; t += 2) {
            const bool last = (t == nt - 2);
            const char* a1 = cA + (size_t)(t + 1) * kstep;
            const char* a2 = last ? nA : cA + (size_t)(t + 2) * kstep; const char* b2 = last ? nB : cB + (size_t)(t + 2) * kstep;
            const char* a3 = a2 + kstep; const char* b3 = b2 + kstep;
            G_LDB(B0, 0, 0); G_SCHED; G_LDA(At, 0, 0); G_STAGE(G_SA(1, 1), a1 + hstep);
            G_WAIT_L(8); G_BAR; G_WAIT_L(0); G_MMA(0, 0, At, B0); G_BAR; G_SCHED;
            G_LDB(B1, 0, 1); G_STAGE(G_SB(0, 0), b2);
            G_BAR; G_WAIT_L(0); G_MMA(0, 1, At, B1); G_BAR;
            G_LDA(At, 0, 1); G_STAGE(G_SA(0, 0), a2);
            G_BAR; G_WAIT_L(0); G_MMA(1, 0, At, B0); G_BAR; G_SCHED;
            G_STAGE(G_SB(0, 1), b2 + hstep);
            G_WAIT_V(6); G_BAR; G_MMA(1, 1, At, B1); G_BAR;
            G_LDB(B0, 1, 0); G_SCHED; G_LDA(At, 1, 0); G_STAGE(G_SA(0, 1), a2 + hstep);
            G_WAIT_L(8); G_BAR; G_WAIT_L(0); G_MMA(0, 0, At, B0); G_BAR; G_SCHED;
            G_LDB(B1, 1, 1); G_STAGE(G_SB(1, 0), b3);
            G_BAR; G_WAIT_L(0); G_MMA(0, 1, At, B1); G_BAR;
            G_LDA(At, 1, 1); G_STAGE(G_SA(1, 0), a3);
            G_BAR; G_WAIT_L(0); G_MMA(1, 0, At, B0); G_BAR; G_SCHED;
            G_STAGE(G_SB(1, 1), b3 + hstep);
            G_WAIT_V(6); G_BAR; G_MMA(1, 1, At, B1); G_BAR;
        }
        const bool keep = E(acc, cur, wr, wc, fr, fq);
        if (!has_next) break;
        if (!keep) G_ZERO();
        cur = nxt; cA = nA; cB = nB; ++ui;
    }
    G_WAIT_V(0);
    if (wr == 0) G_BAR;
    G_BAR;
#undef G_SA
#undef G_SB
#undef G_STAGE
#undef G_LDA
#undef G_LDB
#undef G_MMA
#undef G_ZERO
}

constexpr size_t TSTEP1024 = (size_t)256 * DM * 2, TSTEP_FF = (size_t)256 * DFF * 2;
struct SchedInProj {
    const char* U; const char* UC; const char* W; int G, c;
    DI bool next(int i, Unit& u) const {
        const int L = i * G + c;
        if (L < 128 * 24) { static_order(L, 128, 24, u.pm, u.pn); u.kind = 0; u.A = U + (size_t)u.pm * TSTEP1024; u.B = W + (size_t)u.pn * TSTEP1024; return true; }
        if (L < 128 * 24 + 64) { const int j = L - 128 * 24; u.pm = j >> 3; u.pn = j & 3; u.kind = 1 + ((j >> 2) & 1); u.A = UC + (size_t)u.pm * TSTEP1024; u.B = W + (size_t)((u.kind == 2 ? 8 : 0) + u.pn) * TSTEP1024; return true; }
        return false;
    }
};
struct SchedPlain {
    const char* A; const char* B; int nM, nN, G, c; size_t tstep;
    DI bool next(int i, Unit& u) const {
        const int L = i * G + c; if (L >= nM * nN) return false;
        static_order(L, nM, nN, u.pm, u.pn); u.kind = 0; u.A = A + (size_t)u.pm * tstep; u.B = B + (size_t)u.pn * tstep; return true;
    }
};
struct SchedBranch {
    const char* A0; const char* B0; const char* A1; const char* B1; int G, c;
    DI bool next(int i, Unit& u) const {
        const int L = (i >> 1) * G + c; if (L >= 128 * 4) return false;
        static_order(L, 128, 4, u.pm, u.pn); u.kind = i & 1;
        u.A = (u.kind ? A1 : A0) + (size_t)u.pm * TSTEP1024; u.B = (u.kind ? B1 : B0) + (size_t)u.pn * TSTEP1024; return true;
    }
};
#define EPI_LOOP(...) _Pragma("unroll") for (int ai = 0; ai < 2; ++ai) _Pragma("unroll") for (int m = 0; m < 4; ++m) { const int row = u.pm * 256 + ai * 128 + wr * 64 + m * 16 + fr; \
    _Pragma("unroll") for (int bj = 0; bj < 2; ++bj) _Pragma("unroll") for (int n = 0; n < 2; ++n) { const int ct = bj * 128 + wc * 32 + n * 16 + fq * 4; f32x4& v = acc[ai][bj][m][n]; __VA_ARGS__ } }
struct EpiInProj {
    bf16_t* base; bf16_t* rgxc; bf16_t* mlxc;
    DI bool operator()(Acc& acc, const Unit& u, int wr, int wc, int fr, int fq) const {
        if (u.kind == 0) {
            const int t = u.pn >> 2; bf16_t* dst = base + (size_t)t * MROWS * DM + (u.pn & 3) * 256;
            EPI_LOOP(
                if (t == 1) { v[0] = gelu_tanh(v[0]); v[1] = gelu_tanh(v[1]); v[2] = gelu_tanh(v[2]); v[3] = gelu_tanh(v[3]); }
                else if (t >= 3) { v[0] = sigmoidf_(v[0]); v[1] = sigmoidf_(v[1]); v[2] = sigmoidf_(v[2]); v[3] = sigmoidf_(v[3]); }
                *(uint2*)(dst + (size_t)row * DM + ct) = pack4(v[0], v[1], v[2], v[3]); )
        } else {
            bf16_t* dst = (u.kind == 1 ? rgxc : mlxc) + u.pn * 256;
            EPI_LOOP( *(uint2*)(dst + (size_t)row * DM + ct) = pack4(v[0], v[1], v[2], v[3]); )
        }
        return false;
    }
};
struct EpiBranch {
    const bf16_t* sgr; const bf16_t* sgm; bf16_t* mix;
    DI bool operator()(Acc& acc, const Unit& u, int wr, int wc, int fr, int fq) const {
        if (u.kind == 0) {
            EPI_LOOP( const size_t o = (size_t)row * DM + u.pn * 256 + ct; float a[4], b[4]; unpack4(*(const uint2*)(sgr + o), a); unpack4(*(const uint2*)(sgm + o), b);
                v[0] *= a[0] / b[0]; v[1] *= a[1] / b[1]; v[2] *= a[2] / b[2]; v[3] *= a[3] / b[3]; )
            return true;
        }
        EPI_LOOP( const size_t o = (size_t)row * DM + u.pn * 256 + ct; float b[4]; unpack4(*(const uint2*)(sgm + o), b);
            *(uint2*)(mix + o) = pack4(v[0] * b[0], v[1] * b[1], v[2] * b[2], v[3] * b[3]); )
        return false;
    }
};
struct EpiOutProj {
    const float* x; const float* modl; float* x1;
    DI bool operator()(Acc& acc, const Unit& u, int wr, int wc, int fr, int fq) const {
        const float* g1 = modl + (u.pm >> 4) * NIN + 2048 + u.pn * 256;
        EPI_LOOP( const size_t o = (size_t)row * DM + u.pn * 256 + ct; const float4 g = *(const float4*)(g1 + ct), xx = *(const float4*)(x + o);
            float4 r; r.x = xx.x + g.x * v[0]; r.y = xx.y + g.y * v[1]; r.z = xx.z + g.z * v[2]; r.w = xx.w + g.w * v[3]; *(float4*)(x1 + o) = r; )
        return false;
    }
};
struct EpiFfnIn {
    bf16_t* act;
    DI bool operator()(Acc& acc, const Unit& u, int wr, int wc, int fr, int fq) const {
#pragma unroll
        for (int ai = 0; ai < 2; ++ai)
#pragma unroll
            for (int m = 0; m < 4; ++m) { const int row = u.pm * 256 + ai * 128 + wr * 64 + m * 16 + fr;
#pragma unroll
                for (int n = 0; n < 2; ++n) { const f32x4 g = acc[ai][0][m][n], up = acc[ai][1][m][n];
                    *(uint2*)(act + (size_t)row * DFF + u.pn * 128 + wc * 32 + n * 16 + fq * 4) = pack4(siluf_(g[0]) * up[0], siluf_(g[1]) * up[1], siluf_(g[2]) * up[2], siluf_(g[3]) * up[3]); } }
        return false;
    }
};
struct EpiFfnOut {
    float* x12; const float* modl;
    DI bool operator()(Acc& acc, const Unit& u, int wr, int wc, int fr, int fq) const {
        const float* g2 = modl + (u.pm >> 4) * NIN + 5120 + u.pn * 256;
        EPI_LOOP( const size_t o = (size_t)row * DM + u.pn * 256 + ct; const float4 g = *(const float4*)(g2 + ct); float4 xx = *(const float4*)(x12 + o);
            xx.x += g.x * v[0]; xx.y += g.y * v[1]; xx.z += g.z * v[2]; xx.w += g.w * v[3]; *(float4*)(x12 + o) = xx; )
        return false;
    }
};

#endif
__device__ __forceinline__ void phase_rg_naive(const Params& P) {
    const int tid = threadIdx.x, wid = tid >> 6, lane = tid & 63;
    const bf16_t* rgx = (const bf16_t*)(P.ws + OFF_RGX); const bf16_t* rgxc = (const bf16_t*)(P.ws + OFF_RGXC); const bf16_t* ggelu = (const bf16_t*)(P.ws + OFF_GGELU);
    bf16_t* yrg = (bf16_t*)(P.ws + OFF_U); float* HB = P.out;
    for (int item = wid * gridDim.x + blockIdx.x; item < NB * 16; item += gridDim.x * 8) {
        const int b = item >> 4, n = item & 15, ch = n * 64 + lane;
        float cw[4];
#pragma unroll
        for (int j = 0; j < 4; ++j) cw[j] = P.rg_conv_w[j * DM + ch];
        const float cb = P.rg_conv_b[ch];
        for (int pass = 0; pass < 2; ++pass) {
            const int d = 1 - pass;
            float wa_r[64], wx_r[64];
#pragma unroll
            for (int i = 0; i < 64; ++i) { wa_r[i] = P.rg_wa[((size_t)(d * 16 + n) * 64 + i) * 64 + lane]; wx_r[i] = P.rg_wx[((size_t)(d * 16 + n) * 64 + i) * 64 + lane]; }
            const float ba = P.rg_ba[d * DM + ch], bx = P.rg_bx[d * DM + ch];
            const float cA = -8.0f * softplusf_(-P.rg_lambda[d * DM + ch]);
            float h = 0.f;
            for (int sq = 0; sq < 2; ++sq) {
                const int Ls = sq ? SEQ : CTXL;
                const bf16_t* X = sq ? rgx + (size_t)b * SEQ * DM : rgxc + (size_t)b * CTXL * DM;
                for (int s = 0; s < Ls; ++s) {
                    const int t = d ? Ls - 1 - s : s;
                    float xc = cb;
#pragma unroll
                    for (int j = 0; j < 4; ++j) { const int tt = t + j - 2; if (tt >= 0 && tt < Ls) xc += cw[j] * bf2f(X[(size_t)tt * DM + ch]); }
                    float ra = ba, ri = bx;
#pragma unroll
                    for (int i = 0; i < 64; ++i) { const float xi = __int_as_float(__builtin_amdgcn_readlane(__float_as_int(xc), i)); ra += xi * wa_r[i]; ri += xi * wx_r[i]; }
                    const float r = sigmoidf_(ra), ig = sigmoidf_(ri);
                    const float log_a = cA * r, a = expf(log_a), bb = sqrtf(-expm1f(2.0f * log_a)) * (ig * xc);
                    h = a * h + bb;
                    if (sq) {
                        const size_t o = ((size_t)b * SEQ + t) * DM + ch;
                        if (d) HB[o] = h; else yrg[o] = f2bf((h + HB[o]) * bf2f(ggelu[o]));
                    }
                }
            }
        }
    }
}

constexpr int RG_WTOT = 0, RG_XCS = 4096, RG_CWT = RG_XCS + 8 * 16 * 33 * 4, RG_LDS = RG_CWT + 64 * 8 * 4;
DI float neg_expm1(float x) {
    return x > -0.1f ? -x * (1.0f + x * (0.5f + x * (0.16666667f + x * 0.041666668f))) : 1.0f - __expf(x);
}
template <int d>
__device__ __forceinline__ void rg_pass(const Params& P, char* smem, const int b, const int n, const int half) {
    const int tid = threadIdx.x, wid = tid >> 6, lane0 = tid & 63;
    const bf16_t* rgx = (const bf16_t*)(P.ws + OFF_RGX) + (size_t)b * SEQ * DM; const bf16_t* rgxc = (const bf16_t*)(P.ws + OFF_RGXC) + (size_t)b * CTXL * DM;
    const bf16_t* ggelu = (const bf16_t*)(P.ws + OFF_GGELU) + (size_t)b * SEQ * DM; bf16_t* yrg = (bf16_t*)(P.ws + OFF_U) + (size_t)b * SEQ * DM; float* HB = P.out + (size_t)b * SEQ * DM;
    bf16x8 wfa[2][2], wfx[2][2];
    float ba[2], bx[2], cA[2];
    {
        const int fr = lane0 & 15, fq = lane0 >> 4;
#pragma unroll
        for (int ks = 0; ks < 2; ++ks)
#pragma unroll
            for (int nt = 0; nt < 2; ++nt)
#pragma unroll
                for (int j = 0; j < 8; ++j) { const size_t wi_ = ((size_t)(d * 16 + n) * 64 + 32 * ks + 8 * fq + j) * 64 + 32 * half + 16 * nt + fr;
                    wfa[ks][nt][j] = (short)f2bf(P.rg_wa[wi_]); wfx[ks][nt][j] = (short)f2bf(P.rg_wx[wi_]); }
#pragma unroll
        for (int nt = 0; nt < 2; ++nt) { const int ch = 64 * n + 32 * half + 16 * nt + fr; ba[nt] = P.rg_ba[d * DM + ch]; bx[nt] = P.rg_bx[d * DM + ch]; cA[nt] = -8.0f * softplusf_(-P.rg_lambda[d * DM + ch]); }
    }
    float hc[2] = {0.f, 0.f};
    uint4 raw[4][2];
    auto tile_geo = [&](int ti_, int& sq, int& T0, int& Ls) { sq = ti_ >= 2; const int k = sq ? ti_ - 2 : ti_, nts = sq ? 32 : 2; T0 = 128 * (d ? nts - 1 - k : k); Ls = sq ? SEQ : CTXL; };
    auto load_raw = [&](int ti_, const int lane) {
        int sq, T0, Ls; tile_geo(ti_, sq, T0, Ls);
        const int fr = lane & 15, fq = lane >> 4, tauA = 16 * wid + fr, tA = d ? T0 + 127 - tauA : T0 + tauA;
        const bf16_t* X = sq ? rgx : rgxc;
#pragma unroll
        for (int j = 0; j < 4; ++j) { const int tt = tA + j - 2; const bool ok = tt >= 0 && tt < Ls; const int tc = ok ? tt : tA;
#pragma unroll
            for (int ks = 0; ks < 2; ++ks) { uint4 v = *(const uint4*)(X + (size_t)tc * DM + 64 * n + 32 * ks + 8 * fq); if (!ok) { v.x = v.y = v.z = v.w = 0u; } raw[j][ks] = v; } }
    };
    load_raw(0, lane0);
    for (int ti_ = 0; ti_ < 34; ++ti_) {
        int lane = lane0; LAUNDER(lane);
        const int fr = lane & 15, fq = lane >> 4;
        int sq, T0, Ls; tile_geo(ti_, sq, T0, Ls);
        float hbv[2][4]; bf16_t ggv[2][4];
        if (sq && d == 0) {
#pragma unroll
            for (int nt = 0; nt < 2; ++nt)
#pragma unroll
                for (int j = 0; j < 4; ++j) { const int tau = 16 * wid + 4 * fq + j, t = T0 + tau; const size_t o = (size_t)t * DM + 64 * n + 32 * half + 16 * nt + fr; hbv[nt][j] = HB[o]; ggv[nt][j] = ggelu[o]; }
        }
        bf16x8 af[2];
        {
            const float* cwt = (const float*)(smem + RG_CWT);
            float* xcs = (float*)(smem + RG_XCS) + wid * 16 * 33;
#pragma unroll
            for (int ks = 0; ks < 2; ++ks) {
                float u[4][8];
#pragma unroll
                for (int j = 0; j < 4; ++j) { uint2 lo, hi; lo.x = raw[j][ks].x; lo.y = raw[j][ks].y; hi.x = raw[j][ks].z; hi.y = raw[j][ks].w; float a4[4], b4[4]; unpack4(lo, a4); unpack4(hi, b4);
#pragma unroll
                    for (int c = 0; c < 4; ++c) { u[j][c] = a4[c]; u[j][4 + c] = b4[c]; } }
                float xa[8];
#pragma unroll
                for (int c = 0; c < 8; ++c) { const float4 w = *(const float4*)(cwt + (32 * ks + 8 * fq + c) * 8); const float bb = cwt[(32 * ks + 8 * fq + c) * 8 + 4];
                    xa[c] = bb + w.x * u[0][c] + w.y * u[1][c] + w.z * u[2][c] + w.w * u[3][c]; }
                const uint2 p0 = pack4(xa[0], xa[1], xa[2], xa[3]), p1 = pack4(xa[4], xa[5], xa[6], xa[7]);
                uint4 pk; pk.x = p0.x; pk.y = p0.y; pk.z = p1.x; pk.w = p1.y; af[ks] = __builtin_bit_cast(bf16x8, pk);
                if (ks == half) {
#pragma unroll
                    for (int c = 0; c < 8; ++c) xcs[fr * 33 + 8 * fq + c] = xa[c];
                }
            }
        }
        if (ti_ + 1 < 34) load_raw(ti_ + 1, lane);
        f32x4 Da[2], Dx[2];
#pragma unroll
        for (int nt = 0; nt < 2; ++nt) {
            Da[nt] = __builtin_amdgcn_mfma_f32_16x16x32_bf16(af[0], wfa[0][nt], (f32x4){0.f, 0.f, 0.f, 0.f}, 0, 0, 0);
            Da[nt] = __builtin_amdgcn_mfma_f32_16x16x32_bf16(af[1], wfa[1][nt], Da[nt], 0, 0, 0);
            Dx[nt] = __builtin_amdgcn_mfma_f32_16x16x32_bf16(af[0], wfx[0][nt], (f32x4){0.f, 0.f, 0.f, 0.f}, 0, 0, 0);
            Dx[nt] = __builtin_amdgcn_mfma_f32_16x16x32_bf16(af[1], wfx[1][nt], Dx[nt], 0, 0, 0);
        }
        float av[2][4], bv[2][4], Aq[2], Bq[2];
        {
            const float* xcs = (const float*)(smem + RG_XCS) + wid * 16 * 33;
#pragma unroll
            for (int nt = 0; nt < 2; ++nt) {
                float A = 1.f, B = 0.f;
#pragma unroll
                for (int j = 0; j < 4; ++j) {
                    const float xc = xcs[(4 * fq + j) * 33 + 16 * nt + fr];
                    const float r = sigmoidf_(Da[nt][j] + ba[nt]), ig = sigmoidf_(Dx[nt][j] + bx[nt]);
                    const float log_a = cA[nt] * r, a = __expf(log_a), bb = sqrtf(neg_expm1(2.0f * log_a)) * (ig * xc);
                    av[nt][j] = a; bv[nt][j] = bb; B = a * B + bb; A *= a;
                }
                float Ap = __shfl_up(A, 16), Bp = __shfl_up(B, 16);
                if (fq >= 1) { B = A * Bp + B; A = A * Ap; }
                Ap = __shfl_up(A, 32); Bp = __shfl_up(B, 32);
                if (fq >= 2) { B = A * Bp + B; A = A * Ap; }
                Aq[nt] = A; Bq[nt] = B;
            }
        }
        float* wtot = (float*)(smem + RG_WTOT) + (ti_ & 1) * 512;
        if (fq == 3) {
#pragma unroll
            for (int nt = 0; nt < 2; ++nt) { wtot[(wid * 32 + 16 * nt + fr) * 2] = Aq[nt]; wtot[(wid * 32 + 16 * nt + fr) * 2 + 1] = Bq[nt]; }
        }
        __syncthreads();
#pragma unroll
        for (int nt = 0; nt < 2; ++nt) {
            float Ae = __shfl_up(Aq[nt], 16), Be = __shfl_up(Bq[nt], 16);
            if (fq == 0) { Ae = 1.f; Be = 0.f; }
            float h = hc[nt], hw = hc[nt];
#pragma unroll
            for (int w = 0; w < 8; ++w) { const float Aw = wtot[(w * 32 + 16 * nt + fr) * 2], Bw = wtot[(w * 32 + 16 * nt + fr) * 2 + 1]; h = Aw * h + Bw; if (w < wid) hw = h; }
            hc[nt] = h;
            float hh = Ae * hw + Be;
#pragma unroll
            for (int j = 0; j < 4; ++j) {
                hh = av[nt][j] * hh + bv[nt][j];
                if (sq) {
                    const int tau = 16 * wid + 4 * fq + j, t = d ? T0 + 127 - tau : T0 + tau; const size_t o = (size_t)t * DM + 64 * n + 32 * half + 16 * nt + fr;
                    if (d) HB[o] = hh; else yrg[o] = f2bf((hh + hbv[nt][j]) * bf2f(ggv[nt][j]));
                }
            }
        }
    }
}
__device__ __forceinline__ void phase_rg(const Params& P, char* smem) {
    for (int item = blockIdx.x; item < 256; item += gridDim.x) {
        const int half = item & 1, n = (item >> 1) & 15, b = item >> 5;
        __syncthreads();
        float* cwt = (float*)(smem + RG_CWT);
        for (int i = threadIdx.x; i < 64 * 8; i += 512) { const int ch = i >> 3, e = i & 7; cwt[i] = e < 4 ? P.rg_conv_w[e * DM + 64 * n + ch] : (e == 4 ? P.rg_conv_b[64 * n + ch] : 0.f); }
        __syncthreads();
        rg_pass<1>(P, smem, b, n, half);
        __syncthreads();
        rg_pass<0>(P, smem, b, n, half);
    }
}

DI const bf16_t* ml_row(const Params& P, int b, int sq, int pos) {
    return sq ? (const bf16_t*)(P.ws + OFF_MLX) + ((size_t)b * SEQ + lat_tok(pos)) * DM : (const bf16_t*)(P.ws + OFF_MLXC) + ((size_t)b * CTXL + pos) * DM;
}
__device__ __forceinline__ void phase_mlpre(const Params& P, char* smem) {
    float* gin = (float*)smem;
    const int tid = threadIdx.x, slot = tid >> 8, g = tid & 255, wid = tid >> 6, lane = tid & 63;
    float* logi = (float*)(P.ws + OFF_LOGI); float* logf_ = (float*)(P.ws + OFF_LOGF);
    for (int tok0 = blockIdx.x * 2; tok0 < NB * LTOT; tok0 += gridDim.x * 2) {
        {
            const int tok = tok0 + slot, b = tok / LTOT, pidx = tok % LTOT, sq = pidx >= CTXL, pos = sq ? pidx - CTXL : pidx, Ls = sq ? SEQ : CTXL;
            float uu[4][4];
#pragma unroll
            for (int j = 0; j < 4; ++j) { const int pp = pos + j - 2;
                if (pp >= 0 && pp < Ls) unpack4(*(const uint2*)(ml_row(P, b, sq, pp) + 4 * g), uu[j]); else { uu[j][0] = uu[j][1] = uu[j][2] = uu[j][3] = 0.f; } }
            float xm[4];
#pragma unroll
            for (int c = 0; c < 4; ++c) { float a = P.ml_conv_b[4 * g + c];
#pragma unroll
                for (int j = 0; j < 4; ++j) a += P.ml_conv_w[j * DM + 4 * g + c] * uu[j][c];
                xm[c] = siluf_(a); }
#pragma unroll
            for (int o = 0; o < 4; ++o) { float q = 0.f, k = 0.f, v = 0.f;
#pragma unroll
                for (int i = 0; i < 4; ++i) { q += xm[i] * P.ml_wq[(g * 4 + i) * 4 + o]; k += xm[i] * P.ml_wk[(g * 4 + i) * 4 + o]; v += uu[2][i] * P.ml_wv[(g * 4 + i) * 4 + o]; }
                gin[slot * 3072 + 4 * g + o] = q; gin[slot * 3072 + 1024 + 4 * g + o] = k * 0.0625f; gin[slot * 3072 + 2048 + 4 * g + o] = v; }
        }
        __syncthreads();
        {
            const int ws_ = wid >> 2, gate = (wid >> 1) & 1, d = wid & 1;
            const float4* W = (const float4*)((gate ? P.ml_wf : P.ml_wi) + (size_t)d * 3072 * 4);
            float a0 = 0.f, a1 = 0.f, a2 = 0.f, a3 = 0.f;
            for (int j = lane; j < 3072; j += 64) { const float4 w = W[j]; const float gv = gin[ws_ * 3072 + j]; a0 += gv * w.x; a1 += gv * w.y; a2 += gv * w.z; a3 += gv * w.w; }
            a0 = wave_sum(a0); a1 = wave_sum(a1); a2 = wave_sum(a2); a3 = wave_sum(a3);
            if (lane == 0) {
                const int tok = tok0 + ws_, b = tok / LTOT, pidx = tok % LTOT;
                const float* bias = (gate ? P.ml_bf : P.ml_bi) + d * 4; float* dst = (gate ? logf_ : logi);
                const float pre[4] = {a0 + bias[0], a1 + bias[1], a2 + bias[2], a3 + bias[3]};
#pragma unroll
                for (int hh = 0; hh < 4; ++hh) dst[((size_t)(b * 2 + d) * 4 + hh) * LTOT + pidx] = gate ? -softplusf_(-pre[hh]) : pre[hh];
            }
        }
        __syncthreads();
    }
}

__device__ __forceinline__ void phase_mlstm_naive(const Params& P, char* smem) {
    float* xm_s = (float*)smem; float* u_s = xm_s + 256; float* q_s = u_s + 256; float* k_s = q_s + 256; float* v_s = k_s + 256;
    const int tid = threadIdx.x, vloc = tid >> 4, kseg = tid & 15;
    const float* logi = (const float*)(P.ws + OFF_LOGI); const float* logf_ = (const float*)(P.ws + OFF_LOGF);
    for (int item = blockIdx.x; item < NB * 4 * 2 * 8; item += gridDim.x) {
        const int vs = item & 7, d = (item >> 3) & 1, hd = (item >> 4) & 3, b = item >> 6;
        bf16_t* Hd = (bf16_t*)(P.ws + (d ? OFF_GGELU : OFF_RGX));
        float C[16], nn[16];
#pragma unroll
        for (int i = 0; i < 16; ++i) { C[i] = 0.f; nn[i] = 0.f; }
        float m = 0.f;
        float cw[4] = {0.f, 0.f, 0.f, 0.f}, cb = 0.f, wq_r[4] = {0.f, 0.f, 0.f, 0.f}, wk_r[4] = {0.f, 0.f, 0.f, 0.f};
        int cg = 0;
        if (tid < 256) { cg = 256 * hd + tid;
#pragma unroll
            for (int j = 0; j < 4; ++j) cw[j] = P.ml_conv_w[j * DM + cg];
            cb = P.ml_conv_b[cg];
#pragma unroll
            for (int i = 0; i < 4; ++i) { wq_r[i] = P.ml_wq[((cg >> 2) * 4 + i) * 4 + (cg & 3)]; wk_r[i] = P.ml_wk[((cg >> 2) * 4 + i) * 4 + (cg & 3)]; }
        } else if (tid < 288) { cg = 256 * hd + 32 * vs + (tid - 256);
#pragma unroll
            for (int i = 0; i < 4; ++i) wq_r[i] = P.ml_wv[((cg >> 2) * 4 + i) * 4 + (cg & 3)];
        }
        for (int sq = 0; sq < 2; ++sq) {
            const int Ls = sq ? SEQ : CTXL, lo = sq ? CTXL : 0;
            for (int s = 0; s < Ls; ++s) {
                const int pos = d ? Ls - 1 - s : s;
                if (tid < 256) {
                    float a = cb, ucur = 0.f;
#pragma unroll
                    for (int j = 0; j < 4; ++j) { const int pp = pos + j - 2; if (pp >= 0 && pp < Ls) { const float uv = bf2f(ml_row(P, b, sq, pp)[cg]); a += cw[j] * uv; if (j == 2) ucur = uv; } }
                    xm_s[tid] = siluf_(a); u_s[tid] = ucur;
                }
                __syncthreads();
                if (tid < 256) { const int g4 = tid & ~3; float q = 0.f, k = 0.f;
#pragma unroll
                    for (int i = 0; i < 4; ++i) { q += xm_s[g4 + i] * wq_r[i]; k += xm_s[g4 + i] * wk_r[i]; }
                    q_s[tid] = q; k_s[tid] = k * 0.0625f;
                } else if (tid < 288) { const int j = tid - 256, g4 = (32 * vs + j) & ~3; float v = 0.f;
#pragma unroll
                    for (int i = 0; i < 4; ++i) v += u_s[g4 + i] * wq_r[i];
                    v_s[j] = v; }
                __syncthreads();
                const size_t gi = ((size_t)(b * 2 + d) * 4 + hd) * LTOT + lo + pos;
                const float li = logi[gi], lf = logf_[gi];
                const float m_new = fmaxf(lf + m, li), fd = expf(lf + m - m_new), iw = expf(li - m_new);
                const float vv = v_s[vloc] * iw; float num = 0.f, den = 0.f;
#pragma unroll
                for (int kk = 0; kk < 16; ++kk) { const float kq = k_s[kseg * 16 + kk], qq = q_s[kseg * 16 + kk];
                    C[kk] = fd * C[kk] + vv * kq; nn[kk] = fd * nn[kk] + iw * kq; num += C[kk] * qq; den += nn[kk] * qq; }
#pragma unroll
                for (int o = 8; o > 0; o >>= 1) { num += __shfl_xor(num, o); den += __shfl_xor(den, o); }
                if (sq && kseg == 0) Hd[((size_t)b * SEQ + pos) * DM + 256 * hd + 32 * vs + vloc] = f2bf(num / fmaxf(fabsf(den), expf(-m_new)));
                m = m_new;
            }
        }
        __syncthreads();
    }
}

constexpr int ML_RAW = 0, ML_QS = 512, ML_KS = ML_QS + 64 * 528, ML_CS = ML_KS + 64 * 528, ML_VT = ML_CS + 80 * 528, ML_VW = ML_VT + 80 * 144, ML_SS = ML_VW + 80 * 144, ML_SC = ML_SS + 64 * 144,
              ML_SCB = 1536, ML_WT = ML_SC + 2 * ML_SCB, ML_LDS = ML_WT + 64 * 69 * 4;
typedef short s16x4 __attribute__((ext_vector_type(4)));
DI float wave_incl_sum(float v, int lane) {
#pragma unroll
    for (int o = 1; o < 64; o <<= 1) { const float t = __shfl_up(v, o); if (lane >= o) v += t; }
    return v;
}
DI float wave_incl_max(float v, int lane) {
#pragma unroll
    for (int o = 1; o < 64; o <<= 1) { const float t = __shfl_up(v, o); if (lane >= o) v = fmaxf(v, t); }
    return v;
}
struct MlChunk { int sq, P0, Ls, lo; };
DI MlChunk ml_chunk(int cidx, int d) { MlChunk c; c.sq = cidx >= 4; const int blk = c.sq ? cidx - 4 : cidx, nblk = c.sq ? 64 : 4; c.P0 = 64 * (d ? nblk - 1 - blk : blk); c.Ls = c.sq ? SEQ : CTXL; c.lo = c.sq ? CTXL : 0; return c; }

template <int d>
__device__ __forceinline__ void mlstm_item(const Params& P, char* smem, const int vq, const int hd, const int b) {
    const int tid = threadIdx.x, wid = tid >> 6, lane0 = tid & 63;
    bf16_t* Qs = (bf16_t*)(smem + ML_QS); bf16_t* Ks = (bf16_t*)(smem + ML_KS); bf16_t* Cs = (bf16_t*)(smem + ML_CS);
    bf16_t* VT = (bf16_t*)(smem + ML_VT); bf16_t* VW = (bf16_t*)(smem + ML_VW); bf16_t* Ss = (bf16_t*)(smem + ML_SS);
    const float* logi = (const float*)(P.ws + OFF_LOGI); const float* logf_ = (const float*)(P.ws + OFF_LOGF);
    const int ti = wid >> 1, pr = wid & 1;
    bf16_t* Hd = (bf16_t*)(P.ws + (d ? OFF_GGELU : OFF_RGX));
    const size_t chain = ((size_t)(b * 2 + d) * 4 + hd) * LTOT;
    __syncthreads();
    float* wt = (float*)(smem + ML_WT);
    for (int i = tid; i < 64 * 68; i += 512) { const int gg = i / 68, e = i % 68, cgg = 256 * hd + 4 * gg; float v;
        if (e < 48) { const int which = e >> 4, wi_ = (cgg >> 2) * 16 + (e & 15); v = which == 0 ? P.ml_wq[wi_] : which == 1 ? P.ml_wk[wi_] * 0.0625f : P.ml_wv[wi_]; }
        else if (e < 64) { const int j = (e - 48) >> 2, c = (e - 48) & 3; v = P.ml_conv_w[j * DM + cgg + c]; }
        else v = P.ml_conv_b[cgg + (e - 64)];
        wt[gg * 69 + e] = v; }
    f32x4 X[2][5];
#pragma unroll
    for (int x = 0; x < 2; ++x)
#pragma unroll
        for (int vi = 0; vi < 5; ++vi) X[x][vi] = (f32x4){0.f, 0.f, 0.f, 0.f};
    for (int i = tid; i < 80 * 264 / 2; i += 512) ((unsigned*)Cs)[i] = 0u;
    for (int i = tid; i < 16 * 72; i += 512) { VT[64 * 72 + i] = (i < 72) ? (bf16_t)0x3F80 : (bf16_t)0; VW[64 * 72 + i] = 0; }
    float m_run = 0.f;
    auto scalars = [&](int cidx, const int lane) {
        const MlChunk c = ml_chunk(cidx, d);
        float* sc = (float*)(smem + ML_SC + (cidx & 1) * ML_SCB);
        const size_t gi = chain + c.lo + c.P0 + (d ? 63 - lane : lane);
        const float li = logi[gi], lf = logf_[gi];
        const float bcum = wave_incl_sum(lf, lane), colv = li - bcum, pmax = wave_incl_max(colv, lane);
        const float M = fmaxf(m_run, pmax), M63 = __shfl(M, 63), bL = __shfl(bcum, 63);
        sc[lane] = M; sc[64 + lane] = colv; sc[128 + lane] = expf(m_run - M); sc[192 + lane] = expf(-(bcum + M)); sc[256 + lane] = expf(colv - M63);
        if (lane == 0) sc[320] = expf(m_run - M63);
        m_run = bL + M63;
    };
    auto dma_raw = [&](int cidx, const int lane) {
        const MlChunk c = ml_chunk(cidx, d);
#pragma unroll
        for (int it = 0; it < 5; ++it) {
            int k = wid + 8 * it; if (it == 4) { if (wid > 1) break; k = 32 + wid; }
            const int rho0 = (k == 33) ? 65 : 2 * k, rho = rho0 + (lane >> 5);
            int pp = c.P0 + rho - 2; pp = pp < 0 ? 0 : (pp >= c.Ls ? c.Ls - 1 : pp);
            const char* gp = (const char*)(ml_row(P, b, c.sq, pp) + 256 * hd) + (lane & 31) * 16;
#ifndef EMU
            __builtin_amdgcn_global_load_lds((const unsigned*)gp, (LAS unsigned*)(smem + ML_RAW + rho0 * 512), 16, 0, 0);
#else
            memcpy(smem + ML_RAW + rho0 * 512 + lane * 16, gp, 16);
#endif
        }
    };
    uint2 qh[8];
    auto fill_a = [&](int cidx, const int g) {
        const bool isv = (g >> 4) == vq;
        const MlChunk c = ml_chunk(cidx, d);
        const float* sc = (const float*)(smem + ML_SC + (cidx & 1) * ML_SCB);
        const bool zlo = c.P0 == 0, zhi = c.P0 + 64 == c.Ls;
#pragma unroll
        for (int i = 0; i < 8; ++i) {
            const int r = 8 * wid + i, s = d ? 63 - r : r;
            int go = g * 69; LAUNDER(go); const float* wg = (const float*)(smem + ML_WT) + go;
            float u[4][4];
#pragma unroll
            for (int j = 0; j < 4; ++j) { const int rho = r + j; uint2 w = *(const uint2*)(smem + ML_RAW + rho * 512 + 8 * g);
                if ((zlo && rho < 2) || (zhi && rho > 65)) { w.x = 0u; w.y = 0u; }
                unpack4(w, u[j]); }
            float xm[4];
#pragma unroll
            for (int cc = 0; cc < 4; ++cc) xm[cc] = siluf_(wg[64 + cc] + wg[48 + cc] * u[0][cc] + wg[52 + cc] * u[1][cc] + wg[56 + cc] * u[2][cc] + wg[60 + cc] * u[3][cc]);
            float q[4], k[4];
#pragma unroll
            for (int o = 0; o < 4; ++o) { q[o] = xm[0] * wg[o] + xm[1] * wg[4 + o] + xm[2] * wg[8 + o] + xm[3] * wg[12 + o];
                k[o] = xm[0] * wg[16 + o] + xm[1] * wg[20 + o] + xm[2] * wg[24 + o] + xm[3] * wg[28 + o]; }
            qh[i] = pack4(q[0], q[1], q[2], q[3]); LAUNDER(qh[i].x); LAUNDER(qh[i].y);
            *(uint2*)(Ks + s * 264 + 4 * g) = pack4(k[0], k[1], k[2], k[3]);
            {
                const float wsv = sc[256 + s]; const int scol = isv ? s : 64 + (s & 7);
#pragma unroll
                for (int o = 0; o < 4; ++o) { const float v = u[2][0] * wg[32 + o] + u[2][1] * wg[36 + o] + u[2][2] * wg[40 + o] + u[2][3] * wg[44 + o];
                    const int vloc = 4 * (g & 15) + o; VT[vloc * 72 + scol] = f2bf(v); VW[vloc * 72 + scol] = f2bf(v * wsv); }
            }
            asm volatile("" ::: "memory"); __builtin_amdgcn_sched_barrier(0);
        }
        if (wid == 0) VW[64 * 72 + g] = f2bf(sc[256 + g]);
    };
    auto fill_b = [&](const int g) {
#pragma unroll
        for (int i = 0; i < 8; ++i) { const int r = 8 * wid + i, s = d ? 63 - r : r; *(uint2*)(Qs + s * 264 + 4 * g) = qh[i]; }
    };
    if (wid == 0) scalars(0, lane0);
    dma_raw(0, lane0);
#ifndef EMU
    asm volatile("s_waitcnt vmcnt(0)" ::: "memory");
#endif
    __syncthreads();
    for (int cidx = 0; cidx < 68; ++cidx) {
        int lane = lane0; LAUNDER(lane);
        const int fr = lane & 15, fq = lane >> 4;
        const MlChunk ck = ml_chunk(cidx, d);
        const float* sc = (const float*)(smem + ML_SC + (cidx & 1) * ML_SCB);
        fill_a(cidx, lane);
        __syncthreads();
        fill_b(lane);
        __syncthreads();
        if (cidx + 1 < 68 && wid == 0) scalars(cidx + 1, lane);
        f32x4 sacc[2], qacc[3];
        sacc[0] = sacc[1] = qacc[0] = qacc[1] = qacc[2] = (f32x4){0.f, 0.f, 0.f, 0.f};
        {
            const bf16_t* qrow = Qs + (16 * ti + fr) * 264 + 8 * fq;
            const bf16_t* k0 = Ks + (32 * pr + fr) * 264 + 8 * fq; const bf16_t* k1 = k0 + 16 * 264;
            const bf16_t* c0 = Cs + (32 * pr + fr) * 264 + 8 * fq; const bf16_t* c1 = c0 + 16 * 264; const bf16_t* c4 = Cs + (64 + fr) * 264 + 8 * fq;
#pragma unroll 2
            for (int ks = 0; ks < 8; ++ks) {
                const bf16x8 a = *(const bf16x8*)(qrow + 32 * ks);
                sacc[0] = __builtin_amdgcn_mfma_f32_16x16x32_bf16(a, *(const bf16x8*)(k0 + 32 * ks), sacc[0], 0, 0, 0);
                sacc[1] = __builtin_amdgcn_mfma_f32_16x16x32_bf16(a, *(const bf16x8*)(k1 + 32 * ks), sacc[1], 0, 0, 0);
                qacc[0] = __builtin_amdgcn_mfma_f32_16x16x32_bf16(a, *(const bf16x8*)(c0 + 32 * ks), qacc[0], 0, 0, 0);
                qacc[1] = __builtin_amdgcn_mfma_f32_16x16x32_bf16(a, *(const bf16x8*)(c1 + 32 * ks), qacc[1], 0, 0, 0);
                qacc[2] = __builtin_amdgcn_mfma_f32_16x16x32_bf16(a, *(const bf16x8*)(c4 + 32 * ks), qacc[2], 0, 0, 0);
            }
        }
#pragma unroll
        for (int s2 = 0; s2 < 2; ++s2) { const int s = 32 * pr + 16 * s2 + fr; const float cv = sc[64 + s];
#pragma unroll
            for (int j = 0; j < 4; ++j) { const int t = 16 * ti + 4 * fq + j; const float w = (s <= t) ? __expf(cv - sc[t]) : 0.f; Ss[t * 72 + s] = f2bf(sacc[s2][j] * w); } }
        __syncthreads();
        if (cidx + 1 < 68) dma_raw(cidx + 1, lane);
#pragma unroll
        for (int j = 0; j < 4; ++j) { const float si_ = sc[128 + 16 * ti + 4 * fq + j]; qacc[0][j] *= si_; qacc[1][j] *= si_; qacc[2][j] *= si_; }
        {
            const bf16_t* srow = Ss + (16 * ti + fr) * 72 + 8 * fq;
            const bf16_t* v0 = VT + (32 * pr + fr) * 72 + 8 * fq; const bf16_t* v1 = v0 + 16 * 72; const bf16_t* v4 = VT + (64 + fr) * 72 + 8 * fq;
#pragma unroll
            for (int k2 = 0; k2 < 2; ++k2) {
                const bf16x8 a = *(const bf16x8*)(srow + 32 * k2);
                qacc[0] = __builtin_amdgcn_mfma_f32_16x16x32_bf16(a, *(const bf16x8*)(v0 + 32 * k2), qacc[0], 0, 0, 0);
                qacc[1] = __builtin_amdgcn_mfma_f32_16x16x32_bf16(a, *(const bf16x8*)(v1 + 32 * k2), qacc[1], 0, 0, 0);
                qacc[2] = __builtin_amdgcn_mfma_f32_16x16x32_bf16(a, *(const bf16x8*)(v4 + 32 * k2), qacc[2], 0, 0, 0);
            }
        }
#pragma unroll
        for (int j = 0; j < 4; ++j) {
            const float den = __shfl(qacc[2][j], lane & 48);
            const int t = 16 * ti + 4 * fq + j;
            const float rdn = frcp(fmaxf(fabsf(den), sc[192 + t]));
            if (ck.sq) {
                const int pos = ck.P0 + (d ? 63 - t : t);
                bf16_t* hp = Hd + ((size_t)b * SEQ + pos) * DM + 256 * hd + 64 * vq + 32 * pr + fr;
                hp[0] = f2bf(qacc[0][j] * rdn); hp[16] = f2bf(qacc[1][j] * rdn);
            }
        }
        {
            const float dec = sc[320];
#pragma unroll
            for (int x = 0; x < 2; ++x)
#pragma unroll
                for (int vi = 0; vi < 5; ++vi) X[x][vi] *= dec;
#pragma unroll
            for (int k2 = 0; k2 < 2; ++k2) {
                bf16x8 a[2];
#pragma unroll
                for (int x = 0; x < 2; ++x) {
                    const bf16_t* pa = Ks + (32 * k2 + 8 * fq + (fr >> 2)) * 264 + 16 * (2 * wid + x) + 4 * (fr & 3);
                    const s16x4 lo = __builtin_amdgcn_ds_read_tr16_b64_v4i16((LAS s16x4*)pa), hi = __builtin_amdgcn_ds_read_tr16_b64_v4i16((LAS s16x4*)(pa + 4 * 264));
                    a[x] = __builtin_shufflevector(lo, hi, 0, 1, 2, 3, 4, 5, 6, 7);
                }
#pragma unroll
                for (int vi = 0; vi < 5; ++vi) {
                    const bf16x8 bv = *(const bf16x8*)(VW + (16 * vi + fr) * 72 + 32 * k2 + 8 * fq);
                    X[0][vi] = __builtin_amdgcn_mfma_f32_16x16x32_bf16(a[0], bv, X[0][vi], 0, 0, 0);
                    X[1][vi] = __builtin_amdgcn_mfma_f32_16x16x32_bf16(a[1], bv, X[1][vi], 0, 0, 0);
                }
            }
#pragma unroll
            for (int x = 0; x < 2; ++x)
#pragma unroll
                for (int vi = 0; vi < 5; ++vi) *(uint2*)(Cs + (16 * vi + fr) * 264 + 16 * (2 * wid + x) + 4 * fq) = pack4(X[x][vi][0], X[x][vi][1], X[x][vi][2], X[x][vi][3]);
        }
#ifndef EMU
        asm volatile("s_waitcnt vmcnt(0)" ::: "memory");
#endif
        __syncthreads();
    }
}
__device__ __forceinline__ void phase_mlstm_chunk(const Params& P, char* smem) {
    for (int item = blockIdx.x; item < 256; item += gridDim.x) {
        const int vq = item & 3, d = (item >> 2) & 1, hd = (item >> 3) & 3, b = item >> 5;
        if (d) mlstm_item<1>(P, smem, vq, hd, b); else mlstm_item<0>(P, smem, vq, hd, b);
    }
}

__device__ __forceinline__ void phase_yml(const Params& P) {
    const int lane = threadIdx.x & 63, gw = (blockIdx.x * blockDim.x + threadIdx.x) >> 6, nw = (gridDim.x * blockDim.x) >> 6;
    const bf16_t* hf = (const bf16_t*)(P.ws + OFF_RGX); const bf16_t* hb = (const bf16_t*)(P.ws + OFF_GGELU); const bf16_t* smlo = (const bf16_t*)(P.ws + OFF_SMLO);
    bf16_t* yml = (bf16_t*)P.out;
    for (int idx = gw; idx < NB * SEQ; idx += nw) {
        const int b = idx >> 12, p = idx & 4095, t = lat_tok(p);
        const size_t hrow = ((size_t)b * SEQ + p) * DM, orow = ((size_t)b * SEQ + t) * DM;
        uint2 outw[4];
#pragma unroll
        for (int i = 0; i < 4; ++i) {
            const int c0 = 256 * i + 4 * lane;
            float a[4], bb[4], hv[4];
            unpack4(*(const uint2*)(hf + hrow + c0), a); unpack4(*(const uint2*)(hb + hrow + c0), bb);
#pragma unroll
            for (int j = 0; j < 4; ++j) hv[j] = a[j] + bb[j];
            const float mu = wave_sum(hv[0] + hv[1] + hv[2] + hv[3]) * (1.0f / 256.0f);
            float dv[4], q = 0.f;
#pragma unroll
            for (int j = 0; j < 4; ++j) { dv[j] = hv[j] - mu; q += dv[j] * dv[j]; }
            const float rs = rsqrtf(wave_sum(q) * (1.0f / 256.0f) + EPS);
            float acc[4];
#pragma unroll
            for (int j = 0; j < 4; ++j) acc[j] = P.ml_conv_b[c0 + j];
#pragma unroll
            for (int jj = 0; jj < 4; ++jj) { const int pp = p + jj - 2; if (pp >= 0 && pp < SEQ) { float uv[4]; unpack4(*(const uint2*)(ml_row(P, b, 1, pp) + c0), uv);
#pragma unroll
                for (int j = 0; j < 4; ++j) acc[j] += P.ml_conv_w[jj * DM + c0 + j] * uv[j]; } }
            float sg[4]; unpack4(*(const uint2*)(smlo + orow + c0), sg);
            float y[4];
#pragma unroll
            for (int j = 0; j < 4; ++j) y[j] = (dv[j] * rs * P.ml_norm_g[c0 + j] + P.ml_skip[c0 + j] * siluf_(acc[j])) * sg[j];
            outw[i] = pack4(y[0], y[1], y[2], y[3]);
        }
#pragma unroll
        for (int i = 0; i < 4; ++i) *(uint2*)(yml + orow + 256 * i + 4 * lane) = outw[i];
    }
}

#ifndef EMU
constexpr int SMEM_BYTES = ML_LDS > GEMM_LDS ? ML_LDS : GEMM_LDS;
__global__ void __launch_bounds__(512) fwd_mega(Params P) {
    extern __shared__ __attribute__((aligned(16))) unsigned char dyn_lds[];
    char* smem = (char*)dyn_lds;
    LAS unsigned char* lds = (LAS unsigned char*)dyn_lds;
    cg::grid_group grid = cg::this_grid();
    char* ws = P.ws;
    const int G = gridDim.x, c = blockIdx.x;
    const float* modl = (const float*)(ws + OFF_MODL);
    phase_prep(P, smem);
    grid.sync();
    phase_u(P);
    grid.sync();
    { SchedInProj s{ws + OFF_U, ws + OFF_UC, ws + OFF_WINT, G, c}; EpiInProj e{(bf16_t*)(ws + OFF_RGX), (bf16_t*)(ws + OFF_RGXC), (bf16_t*)(ws + OFF_MLXC)}; gemm8(lds, DM, s, e); }
    grid.sync();
    phase_rg(P, smem);
    phase_mlpre(P, smem);
    grid.sync();
    phase_mlstm_chunk(P, smem);
    grid.sync();
    phase_yml(P);
    grid.sync();
    { SchedBranch s{ws + OFF_U, ws + OFF_WBRG, (const char*)P.out, ws + OFF_WBML, G, c}; EpiBranch e{(const bf16_t*)(ws + OFF_SGR), (const bf16_t*)(ws + OFF_SGM), (bf16_t*)(ws + OFF_MLX)}; gemm8(lds, DM, s, e); }
    grid.sync();
    { SchedPlain s{ws + OFF_MLX, ws + OFF_WOUT, 128, 4, G, c, TSTEP1024}; EpiOutProj e{P.x, modl, P.out}; gemm8(lds, DM, s, e); }
    grid.sync();
    phase_h2(P);
    grid.sync();
    { SchedPlain s{ws + OFF_U, ws + OFF_FFNIN, 128, 22, G, c, TSTEP1024}; EpiFfnIn e{(bf16_t*)(ws + OFF_RGX)}; gemm8(lds, DM, s, e); }
    grid.sync();
    { SchedPlain s{ws + OFF_RGX, ws + OFF_FFNOUT, 128, 4, G, c, TSTEP_FF}; EpiFfnOut e{P.out, modl}; gemm8(lds, DFF, s, e); }
    grid.sync();
    phase_final(P);
}

extern "C" void kernel_launch(void* const* d_in, const int* in_sizes, int n_in, void* d_out, int out_size, void* d_ws, size_t ws_size, hipStream_t stream) {
    (void)in_sizes; (void)n_in; (void)out_size;
    if (ws_size < WS_TOTAL) { fprintf(stderr, "workspace too small: %zu < %zu\n", ws_size, (size_t)WS_TOTAL); return; }
    static int grid_blocks = 0;
    if (!grid_blocks) {
        int dev = 0, cus = 0, per_cu = 0;
        (void)hipGetDevice(&dev);
        (void)hipDeviceGetAttribute(&cus, hipDeviceAttributeMultiprocessorCount, dev);
        if (hipFuncSetAttribute((const void*)fwd_mega, hipFuncAttributeMaxDynamicSharedMemorySize, SMEM_BYTES) != hipSuccess) fprintf(stderr, "hipFuncSetAttribute failed\n");
        (void)hipOccupancyMaxActiveBlocksPerMultiprocessor(&per_cu, fwd_mega, 512, SMEM_BYTES);
        if (per_cu < 1) fprintf(stderr, "occupancy query reports %d blocks per CU\n", per_cu);
        grid_blocks = cus;
    }
    Params P{};
    const float** pp = (const float**)&P;
    for (int i = 0; i < 33; ++i) pp[i] = (const float*)d_in[i];
    P.out = (float*)d_out; P.ws = (char*)d_ws;
    void* args[] = {&P};
    hipError_t e = hipLaunchCooperativeKernel((void*)fwd_mega, dim3(grid_blocks), dim3(512), args, SMEM_BYTES, stream);
    if (e != hipSuccess) fprintf(stderr, "cooperative launch failed: %s (grid %d)\n", hipGetErrorString(e), grid_blocks);
}
#endif
```

```cpp
#ifndef EMU
#include <hip/hip_runtime.h>
#include <hip/hip_cooperative_groups.h>
namespace cg = cooperative_groups;
#include <cstdio>
#include <cstdint>
#define LAS __attribute__((address_space(3)))
#else
#define LAS
#endif

typedef unsigned short bf16_t;
typedef short bf16x8 __attribute__((ext_vector_type(8)));
typedef float f32x4 __attribute__((ext_vector_type(4)));

#define DI __device__ __forceinline__

constexpr int NB = 8, SEQ = 4096, DM = 1024, CTXL = 256, MROWS = NB * SEQ, MCTX = NB * CTXL, DFF = 2816, NIN = 6144, LTOT = SEQ + CTXL;
constexpr float EPS = 1e-6f;

constexpr size_t SZ_ACT = (size_t)MROWS * DM * 2;
constexpr size_t SZ_ACTC = (size_t)MCTX * DM * 2;
constexpr size_t OFF_WINT = 0;
constexpr size_t OFF_WBRG = OFF_WINT + (size_t)NIN * DM * 2;
constexpr size_t OFF_WBML = OFF_WBRG + (size_t)DM * DM * 2;
constexpr size_t OFF_WOUT = OFF_WBML + (size_t)DM * DM * 2;
constexpr size_t OFF_FFNIN = OFF_WOUT + (size_t)DM * DM * 2;
constexpr size_t OFF_FFNOUT = OFF_FFNIN + (size_t)2 * DFF * DM * 2;
constexpr size_t OFF_MODL = OFF_FFNOUT + (size_t)DM * DFF * 2;
constexpr size_t OFF_MODC = OFF_MODL + (size_t)NB * NIN * 4;
constexpr size_t OFF_LOGI = OFF_MODC + (size_t)NIN * 4;
constexpr size_t OFF_LOGF = OFF_LOGI + (size_t)NB * 2 * 4 * LTOT * 4;
constexpr size_t OFF_U = OFF_LOGF + (size_t)NB * 2 * 4 * LTOT * 4;
constexpr size_t OFF_UC = OFF_U + SZ_ACT;
constexpr size_t OFF_RGX = OFF_UC + SZ_ACTC;
constexpr size_t OFF_GGELU = OFF_RGX + SZ_ACT;
constexpr size_t OFF_MLX = OFF_GGELU + SZ_ACT;
constexpr size_t OFF_SMLO = OFF_MLX + SZ_ACT;
constexpr size_t OFF_SGR = OFF_SMLO + SZ_ACT;
constexpr size_t OFF_SGM = OFF_SGR + SZ_ACT;
constexpr size_t OFF_RGXC = OFF_SGM + SZ_ACT;
constexpr size_t OFF_MLXC = OFF_RGXC + SZ_ACTC;
constexpr size_t OFF_WG = OFF_MLXC + SZ_ACTC;
constexpr size_t WS_TOTAL = OFF_WG + (size_t)3 * 32 * 64 * 8 * 2;

struct Params {
    const float *x, *c, *ctx, *c_ctx, *w_mod, *b_mod, *norm1_g, *norm2_g, *w_in, *rg_conv_w, *rg_conv_b, *rg_wa, *rg_ba, *rg_wx, *rg_bx,
        *rg_lambda, *ml_conv_w, *ml_conv_b, *ml_wq, *ml_wk, *ml_wv, *ml_wi, *ml_bi, *ml_wf, *ml_bf, *ml_norm_g, *ml_skip, *w_branch_rg,
        *w_branch_ml, *w_out, *w_ffn_in, *w_ffn_out, *final_norm_g;
    float* out;
    char* ws;
};

DI bf16_t f2bf(float x) { unsigned u = __float_as_uint(x); u += 0x7fffu + ((u >> 16) & 1u); return (bf16_t)(u >> 16); }
DI float bf2f(bf16_t b) { return __uint_as_float(((unsigned)b) << 16); }
#ifndef EMU
#define LAUNDER(p) asm volatile("" : "+v"(p))
#else
#define LAUNDER(p)
#endif
#ifndef EMU
DI float frcp(float x) { return __builtin_amdgcn_rcpf(x); }
#else
DI float frcp(float x) { return 1.0f / x; }
#endif
DI float sigmoidf_(float x) { return frcp(1.0f + __expf(-x)); }
DI float siluf_(float x) { return x * sigmoidf_(x); }
DI float gelu_tanh(float x) { const float u2 = 1.5957691216057308f * (x + 0.044715f * x * x * x); return x * sigmoidf_(u2); }
DI float softplusf_(float x) { return fmaxf(x, 0.f) + log1pf(expf(-fabsf(x))); }
DI float wave_sum(float v) {
#pragma unroll
    for (int o = 32; o > 0; o >>= 1) v += __shfl_xor(v, o);
    return v;
}
DI void unpack4(uint2 w, float (&f)[4]) {
    f[0] = __uint_as_float(w.x << 16); f[1] = __uint_as_float(w.x & 0xffff0000u);
    f[2] = __uint_as_float(w.y << 16); f[3] = __uint_as_float(w.y & 0xffff0000u);
}
#ifndef EMU
typedef __bf16 bf16x2_n __attribute__((ext_vector_type(2)));
typedef float f32x2_n __attribute__((ext_vector_type(2)));
DI unsigned cvt_pk_bf16(float lo, float hi) { const f32x2_n v = {lo, hi}; return __builtin_bit_cast(unsigned, __builtin_convertvector(v, bf16x2_n)); }
#else
DI unsigned cvt_pk_bf16(float lo, float hi) { return (unsigned)f2bf(lo) | ((unsigned)f2bf(hi) << 16); }
#endif
DI uint2 pack4(float a, float b, float c, float d) { uint2 w; w.x = cvt_pk_bf16(a, b); w.y = cvt_pk_bf16(c, d); return w; }
DI int lat_tok(int p) { return (p & 63) * 64 + (p >> 6); }

DI void tr_unit(float* tile  , const float* src, int ldsrc, int k0, int n0src, bf16_t* dst, int lddst, int r0dst) {
    const int tid = threadIdx.x;
#pragma unroll
    for (int i = 0; i < 2; ++i) {
        const int k = (tid >> 4) + 32 * i, n4 = (tid & 15) * 4;
        const float4 v = *(const float4*)(src + (size_t)(k0 + k) * ldsrc + n0src + n4);
        tile[k * 65 + n4 + 0] = v.x; tile[k * 65 + n4 + 1] = v.y; tile[k * 65 + n4 + 2] = v.z; tile[k * 65 + n4 + 3] = v.w;
    }
    __syncthreads();
    {
        const int n = tid >> 3, k8 = (tid & 7) * 8;
        float f[8];
#pragma unroll
        for (int j = 0; j < 8; ++j) f[j] = tile[(k8 + j) * 65 + n];
        uint4 w; const uint2 a = pack4(f[0], f[1], f[2], f[3]), b = pack4(f[4], f[5], f[6], f[7]);
        w.x = a.x; w.y = a.y; w.z = b.x; w.w = b.y;
        *(uint4*)(dst + (size_t)(r0dst + n) * lddst + k0 + k8) = w;
    }
    __syncthreads();
}

constexpr int PREP_T0 = 96 * 16;
constexpr int PREP_T1 = PREP_T0 + 3 * 256;
constexpr int PREP_T2 = PREP_T1 + 88 * 16;
constexpr int PREP_T3 = PREP_T2 + 16 * 44;
constexpr int PREP_T4 = PREP_T3 + 96;
constexpr int PREP_UNITS = PREP_T4 + 96;

__device__ __forceinline__ void phase_prep(const Params& P, char* smem) {
    const int tid = threadIdx.x;
    for (int u = blockIdx.x; u < PREP_UNITS; u += gridDim.x) {
        if (u < PREP_T0) {
            const int nt = u >> 4, kt = u & 15;
            tr_unit((float*)smem, P.w_in, NIN, kt * 64, nt * 64, (bf16_t*)(P.ws + OFF_WINT), DM, nt * 64);
        } else if (u < PREP_T1) {
            const int v = u - PREP_T0, which = v >> 8, w = v & 255, nt = w >> 4, kt = w & 15;
            const float* src = which == 0 ? P.w_branch_rg : which == 1 ? P.w_branch_ml : P.w_out;
            bf16_t* dst = (bf16_t*)(P.ws + (which == 0 ? OFF_WBRG : which == 1 ? OFF_WBML : OFF_WOUT));
            tr_unit((float*)smem, src, DM, kt * 64, nt * 64, dst, DM, nt * 64);
        } else if (u < PREP_T2) {
            const int v = u - PREP_T1, rt = v >> 4, kt = v & 15, R0 = rt * 64, pn = R0 >> 8, rr = R0 & 255;
            const int n0 = rr < 128 ? 128 * pn + rr : DFF + 128 * pn + (rr - 128);
            tr_unit((float*)smem, P.w_ffn_in, 2 * DFF, kt * 64, n0, (bf16_t*)(P.ws + OFF_FFNIN), DM, R0);
        } else if (u < PREP_T3) {
            const int v = u - PREP_T2, nt = v / 44, kt = v % 44;
            tr_unit((float*)smem, P.w_ffn_out, DM, kt * 64, nt * 64, (bf16_t*)(P.ws + OFF_FFNOUT), DFF, nt * 64);
        } else if (u >= PREP_T4) {
            const int e = (u - PREP_T4) * 512 + tid, j = e & 7, ln = (e >> 3) & 63, ks = (e >> 9) & 31, part = e >> 14;
            const int c = 32 * ks + 8 * (ln >> 4) + j, gt = ln & 15, type = gt >> 3, dd = (gt >> 2) & 1, hh = gt & 3;
            ((bf16_t*)(P.ws + OFF_WG))[e] = f2bf((type ? P.ml_wf : P.ml_wi)[((size_t)dd * 3072 + part * 1024 + c) * 4 + hh]);
        } else {
            const int j0 = (u - PREP_T3) * 64, wid = tid >> 6, lane = tid & 63;
            float* s = (float*)smem;
            float* red = s + 9 * 1024;
            for (int i = tid; i < 9 * 1024; i += 512) { const int r = i >> 10, k = i & 1023; const float cv = r < 8 ? P.c[r * 1024 + k] : P.c_ctx[k]; s[i] = siluf_(cv); }
            __syncthreads();
            float acc[9];
#pragma unroll
            for (int r = 0; r < 9; ++r) acc[r] = 0.f;
            for (int kk = 0; kk < 128; ++kk) {
                const int k = wid * 128 + kk; const float w = P.w_mod[(size_t)k * NIN + j0 + lane];
#pragma unroll
                for (int r = 0; r < 9; ++r) acc[r] += s[r * 1024 + k] * w;
            }
#pragma unroll
            for (int r = 0; r < 9; ++r) red[(wid * 9 + r) * 64 + lane] = acc[r];
            __syncthreads();
            for (int i = tid; i < 9 * 64; i += 512) {
                const int r = i >> 6, l = i & 63; float t = 0.f;
#pragma unroll
                for (int w = 0; w < 8; ++w) t += red[(w * 9 + r) * 64 + l];
                t += P.b_mod[j0 + l];
                if (r < 8) ((float*)(P.ws + OFF_MODL))[r * NIN + j0 + l] = t; else ((float*)(P.ws + OFF_MODC))[j0 + l] = t;
            }
            __syncthreads();
        }
    }
}

DI void row_modnorm(const float* xr, const float* g, const float* sh, const float* sc, bf16_t* outr, int lane) {
    float4 v[4]; float ss = 0.f;
#pragma unroll
    for (int i = 0; i < 4; ++i) { v[i] = *(const float4*)(xr + i * 256 + lane * 4); ss += v[i].x * v[i].x + v[i].y * v[i].y + v[i].z * v[i].z + v[i].w * v[i].w; }
    ss = wave_sum(ss);
    const float rs = rsqrtf(ss * (1.0f / 1024.0f) + EPS);
#pragma unroll
    for (int i = 0; i < 4; ++i) {
        const int c = i * 256 + lane * 4;
        const float4 gg = *(const float4*)(g + c), s1 = *(const float4*)(sc + c), s0 = *(const float4*)(sh + c);
        const float a = (v[i].x * rs * gg.x) * (1.f + s1.x) + s0.x, b = (v[i].y * rs * gg.y) * (1.f + s1.y) + s0.y;
        const float cc = (v[i].z * rs * gg.z) * (1.f + s1.z) + s0.z, d = (v[i].w * rs * gg.w) * (1.f + s1.w) + s0.w;
        *(uint2*)(outr + c) = pack4(a, b, cc, d);
    }
}
__device__ __forceinline__ void phase_u(const Params& P) {
    const int lane = threadIdx.x & 63, gw = (blockIdx.x * blockDim.x + threadIdx.x) >> 6, nw = (gridDim.x * blockDim.x) >> 6;
    const float* modl = (const float*)(P.ws + OFF_MODL); const float* modc = (const float*)(P.ws + OFF_MODC);
    for (int r = gw; r < MROWS + MCTX; r += nw) {
        if (r < MROWS) { const int b = r >> 12; row_modnorm(P.x + (size_t)r * DM, P.norm1_g, modl + b * NIN, modl + b * NIN + 1024, (bf16_t*)(P.ws + OFF_U) + (size_t)r * DM, lane); }
        else { const int rc = r - MROWS; row_modnorm(P.ctx + (size_t)rc * DM, P.norm1_g, modc, modc + 1024, (bf16_t*)(P.ws + OFF_UC) + (size_t)rc * DM, lane); }
    }
}
__device__ __forceinline__ void phase_h2(const Params& P) {
    const int lane = threadIdx.x & 63, gw = (blockIdx.x * blockDim.x + threadIdx.x) >> 6, nw = (gridDim.x * blockDim.x) >> 6;
    const float* modl = (const float*)(P.ws + OFF_MODL);
    for (int r = gw; r < MROWS; r += nw) { const int b = r >> 12; row_modnorm(P.out + (size_t)r * DM, P.norm2_g, modl + b * NIN + 3072, modl + b * NIN + 4096, (bf16_t*)(P.ws + OFF_U) + (size_t)r * DM, lane); }
}
__device__ __forceinline__ void phase_final(const Params& P) {
    const int lane = threadIdx.x & 63, gw = (blockIdx.x * blockDim.x + threadIdx.x) >> 6, nw = (gridDim.x * blockDim.x) >> 6;
    for (int r = gw; r < MROWS; r += nw) {
        float* xr = P.out + (size_t)r * DM; float4 v[4]; float ss = 0.f;
#pragma unroll
        for (int i = 0; i < 4; ++i) { v[i] = *(const float4*)(xr + i * 256 + lane * 4); ss += v[i].x * v[i].x + v[i].y * v[i].y + v[i].z * v[i].z + v[i].w * v[i].w; }
        ss = wave_sum(ss);
        const float rs = rsqrtf(ss * (1.0f / 1024.0f) + EPS);
#pragma unroll
        for (int i = 0; i < 4; ++i) { const int c = i * 256 + lane * 4; const float4 gg = *(const float4*)(P.final_norm_g + c);
            float4 o; o.x = v[i].x * rs * gg.x; o.y = v[i].y * rs * gg.y; o.z = v[i].z * rs * gg.z; o.w = v[i].w * rs * gg.w; *(float4*)(xr + c) = o; }
    }
}

#ifndef EMU
constexpr int G_BK = 64, G_HALF = 128, G_HTB = G_HALF * G_BK * 2, GEMM_LDS = 8 * G_HTB;
DI int lds_byte(int r, int c) { const int st = (r >> 4) * 2 + (c >> 5), rr = r & 15, cc = c & 31, ob = rr * 64 + cc * 2; return st * 1024 + (ob ^ (((ob >> 9) & 1) << 5)); }
DI void stage_rc(int b, int& R, int& C) { const int st = b / 1024, sb = b % 1024, swz = sb ^ (((sb >> 9) & 1) << 5); R = (st >> 1) * 16 + swz / 64; C = (st & 1) * 32 + (swz % 64) / 2; }
struct Unit { const char* A; const char* B; int pm, pn, kind; };
DI void static_order(int L, int nM, int nN, int& pm, int& pn) {
    const int q = (nM * nN) >> 3, wgid = (L & 7) * q + (L >> 3), nig = 8 * nN, gid = wgid / nig, w = wgid % nig;
    pm = gid * 8 + (w & 7); pn = w >> 3;
}
typedef f32x4 Acc[2][2][4][2];

DI int perm32(int rho) { const int n = rho >> 4, i = rho & 15; return 8 * (i >> 2) + 4 * n + (i & 3); }
template <class Sched, class Epi>
__device__ __forceinline__ void gemm8(LAS unsigned char* lds, const int K, const Sched& S, const Epi& E) {
    int tid = threadIdx.x; LAUNDER(tid);
    const int wid = __builtin_amdgcn_readfirstlane(tid >> 6), lane = tid & 63, wr = wid >> 2, wc = wid & 3, fr = lane & 15, fq = lane >> 4;
    const int nt = K / G_BK;
    unsigned voffA[2], voffB[2];
#pragma unroll
    for (int i = 0; i < 2; ++i) { int R, C; stage_rc(tid * 16 + i * 8192, R, C); const int Rb = Epi::PERM ? ((R & ~31) + perm32(R & 31)) : R;
        voffA[i] = (unsigned)(R * K + C) * 2u; voffB[i] = (unsigned)(Rb * K + C) * 2u; }
    const size_t kstep = (size_t)(G_BK * 2), hstep = (size_t)G_HALF * K * 2;
    const unsigned ldsw = (unsigned)wid * 1024u;
    const int aoff = lds_byte(wr * 64 + fr, fq * 8), boff = lds_byte(wc * 32 + fr, fq * 8);
#define G_SA(b, h) (((b) * 2 + (h)) * G_HTB)
#define G_SB(b, h) ((4 + (b) * 2 + (h)) * G_HTB)
#define G_STAGE(bufoff, gbase, voff) do { _Pragma("unroll") for (int _i = 0; _i < 2; ++_i) \
        __builtin_amdgcn_global_load_lds((const unsigned*)((const char*)(gbase) + (voff)[_i]), (LAS unsigned*)(lds + (bufoff) + ldsw + _i * 8192), 16, 0, 0); } while (0)
#define G_LDA(dst, b, h) do { _Pragma("unroll") for (int m = 0; m < 4; ++m) _Pragma("unroll") for (int k = 0; k < 2; ++k) dst[m][k] = *(const LAS bf16x8*)(lds + G_SA(b, h) + aoff + m * 2048 + k * 1024); } while (0)
#define G_LDB(dst, b, h) do { _Pragma("unroll") for (int n = 0; n < 2; ++n) _Pragma("unroll") for (int k = 0; k < 2; ++k) dst[n][k] = *(const LAS bf16x8*)(lds + G_SB(b, h) + boff + n * 2048 + k * 1024); } while (0)
#define G_MMA(ai, bj, At, Bt) do { __builtin_amdgcn_s_setprio(1); _Pragma("unroll") for (int m = 0; m < 4; ++m) _Pragma("unroll") for (int n = 0; n < 2; ++n) _Pragma("unroll") for (int k = 0; k < 2; ++k) \
        acc[ai][bj][m][n] = __builtin_amdgcn_mfma_f32_16x16x32_bf16(Bt[n][k], At[m][k], acc[ai][bj][m][n], 0, 0, 0); __builtin_amdgcn_s_setprio(0); } while (0)
#define G_WAIT_V(n) asm volatile("s_waitcnt vmcnt(" #n ")" ::: "memory")
#define G_WAIT_L(n) asm volatile("s_waitcnt lgkmcnt(" #n ")" ::: "memory")
#define G_BAR __builtin_amdgcn_s_barrier()
#define G_SCHED __builtin_amdgcn_sched_barrier(0)
#define G_ZERO() do { _Pragma("unroll") for (int a = 0; a < 2; ++a) _Pragma("unroll") for (int b = 0; b < 2; ++b) _Pragma("unroll") for (int m = 0; m < 4; ++m) _Pragma("unroll") for (int n = 0; n < 2; ++n) acc[a][b][m][n] = (f32x4){0.f, 0.f, 0.f, 0.f}; } while (0)
    Unit cur, nxt; int ui = 0;
    if (!S.next(0, cur)) return;
    Acc acc;
    G_ZERO();
    bf16x8 At[4][2], B0[2][2], B1[2][2];
    const char* cA = cur.A; const char* cB = cur.B;
    G_STAGE(G_SB(0, 0), cB, voffB); G_STAGE(G_SB(0, 1), cB + hstep, voffB); G_STAGE(G_SA(0, 0), cA, voffA); G_STAGE(G_SA(0, 1), cA + hstep, voffA);
    if (wr == 1) G_BAR;
    G_WAIT_V(2); G_BAR;
    G_STAGE(G_SB(1, 0), cB + kstep, voffB); G_STAGE(G_SA(1, 0), cA + kstep, voffA); G_STAGE(G_SB(1, 1), cB + hstep + kstep, voffB);
    G_WAIT_V(6); G_BAR;
    for (;;) {
        const bool has_next = S.next(ui + 1, nxt);
        const char* nA = has_next ? nxt.A : cA; const char* nB = has_next ? nxt.B : cB;
        for (int t = 0; t < nt; t += 2) {
            const bool last = (t == nt - 2);
            const char* a1 = cA + (size_t)(t + 1) * kstep;
            const char* a2 = last ? nA : cA + (size_t)(t + 2) * kstep; const char* b2 = last ? nB : cB + (size_t)(t + 2) * kstep;
            const char* a3 = a2 + kstep; const char* b3 = b2 + kstep;
            G_LDB(B0, 0, 0); G_LDB(B1, 0, 1); G_SCHED; G_LDA(At, 0, 0); G_STAGE(G_SA(1, 1), a1 + hstep, voffA);
            G_WAIT_V(8); G_WAIT_L(0); G_BAR; G_MMA(0, 0, At, B0); G_MMA(0, 1, At, B1); G_BAR; G_SCHED;
            G_LDA(At, 0, 1); G_STAGE(G_SB(0, 0), b2, voffB); G_STAGE(G_SB(0, 1), b2 + hstep, voffB); G_STAGE(G_SA(0, 0), a2, voffA);
            G_WAIT_V(8); G_WAIT_L(0); G_BAR; G_MMA(1, 0, At, B0); G_MMA(1, 1, At, B1); G_BAR; G_SCHED;
            G_LDB(B0, 1, 0); G_LDB(B1, 1, 1); G_SCHED; G_LDA(At, 1, 0); G_STAGE(G_SA(0, 1), a2 + hstep, voffA);
            G_WAIT_V(8); G_WAIT_L(0); G_BAR; G_MMA(0, 0, At, B0); G_MMA(0, 1, At, B1); G_BAR; G_SCHED;
            G_LDA(At, 1, 1); G_STAGE(G_SB(1, 0), b3, voffB); G_STAGE(G_SB(1, 1), b3 + hstep, voffB); G_STAGE(G_SA(1, 0), a3, voffA);
            G_WAIT_V(8); G_WAIT_L(0); G_BAR; G_MMA(1, 0, At, B0); G_MMA(1, 1, At, B1); G_BAR; G_SCHED;
        }
        if (wr == 0) G_BAR;
        const bool keep = E(acc, cur, wr, wc, fr, fq);
        if (!has_next) break;
        if (!keep) G_ZERO();
        cur = nxt; cA = nA; cB = nB; ++ui;
        if (wr == 1) G_BAR;
    }
    G_WAIT_V(0);
    G_BAR;
#undef G_SA
#undef G_SB
#undef G_STAGE
#undef G_LDA
#undef G_LDB
#undef G_MMA
#undef G_ZERO
}

constexpr size_t TSTEP1024 = (size_t)256 * DM * 2, TSTEP_FF = (size_t)256 * DFF * 2;
struct SchedInProj {
    const char* U; const char* UC; const char* W; int G, c;
    DI bool next(int i, Unit& u) const {
        const int L = i * G + c;
        if (L < 128 * 24) { static_order(L, 128, 24, u.pm, u.pn); u.kind = 0; u.A = U + (size_t)u.pm * TSTEP1024; u.B = W + (size_t)u.pn * TSTEP1024; return true; }
        if (L < 128 * 24 + 64) { const int j = L - 128 * 24; u.pm = j >> 3; u.pn = j & 3; u.kind = 1 + ((j >> 2) & 1); u.A = UC + (size_t)u.pm * TSTEP1024; u.B = W + (size_t)((u.kind == 2 ? 8 : 0) + u.pn) * TSTEP1024; return true; }
        return false;
    }
};
struct SchedPlain {
    const char* A; const char* B; int nM, nN, G, c; size_t tstep;
    DI bool next(int i, Unit& u) const {
        const int L = i * G + c; if (L >= nM * nN) return false;
        static_order(L, nM, nN, u.pm, u.pn); u.kind = 0; u.A = A + (size_t)u.pm * tstep; u.B = B + (size_t)u.pn * tstep; return true;
    }
};
struct SchedBranch {
    const char* A0; const char* B0; const char* A1; const char* B1; int G, c;
    DI bool next(int i, Unit& u) const {
        const int L = (i >> 1) * G + c; if (L >= 128 * 4) return false;
        static_order(L, 128, 4, u.pm, u.pn); u.kind = i & 1;
        u.A = (u.kind ? A1 : A0) + (size_t)u.pm * TSTEP1024; u.B = (u.kind ? B1 : B0) + (size_t)u.pn * TSTEP1024; return true;
    }
};
#define EPI_LOOP(...) _Pragma("unroll") for (int ai = 0; ai < 2; ++ai) _Pragma("unroll") for (int m = 0; m < 4; ++m) { const int row = u.pm * 256 + ai * 128 + wr * 64 + m * 16 + fr; \
    _Pragma("unroll") for (int bj = 0; bj < 2; ++bj) _Pragma("unroll") for (int n = 0; n < 2; ++n) { const int ct = bj * 128 + wc * 32 + n * 16 + fq * 4; f32x4& v = acc[ai][bj][m][n]; __VA_ARGS__ } }
#define EPI_LOOP8(...) _Pragma("unroll") for (int ai = 0; ai < 2; ++ai) _Pragma("unroll") for (int m = 0; m < 4; ++m) { const int row = u.pm * 256 + ai * 128 + wr * 64 + m * 16 + fr; \
    _Pragma("unroll") for (int bj = 0; bj < 2; ++bj) { const int ct = bj * 128 + wc * 32 + fq * 8; f32x4& v0 = acc[ai][bj][m][0]; f32x4& v1 = acc[ai][bj][m][1]; __VA_ARGS__ } }
DI uint4 pack8(const f32x4& a, const f32x4& b) { uint4 w; w.x = cvt_pk_bf16(a[0], a[1]); w.y = cvt_pk_bf16(a[2], a[3]); w.z = cvt_pk_bf16(b[0], b[1]); w.w = cvt_pk_bf16(b[2], b[3]); return w; }
DI void unpack8(const uint4 w, float (&f)[8]) {
    f[0] = __uint_as_float(w.x << 16); f[1] = __uint_as_float(w.x & 0xffff0000u); f[2] = __uint_as_float(w.y << 16); f[3] = __uint_as_float(w.y & 0xffff0000u);
    f[4] = __uint_as_float(w.z << 16); f[5] = __uint_as_float(w.z & 0xffff0000u); f[6] = __uint_as_float(w.w << 16); f[7] = __uint_as_float(w.w & 0xffff0000u);
}
struct EpiInProj {
    static constexpr bool PERM = true;
    bf16_t* base; bf16_t* rgxc; bf16_t* mlxc;
    DI bool operator()(Acc& acc, const Unit& u, int wr, int wc, int fr, int fq) const {
        if (u.kind == 0) {
            const int t = u.pn >> 2; bf16_t* dst = base + (size_t)t * MROWS * DM + (u.pn & 3) * 256;
            EPI_LOOP8(
                if (t == 1) {
                    _Pragma("unroll") for (int j = 0; j < 4; ++j) { v0[j] = gelu_tanh(v0[j]); v1[j] = gelu_tanh(v1[j]); } }
                else if (t >= 3) {
                    _Pragma("unroll") for (int j = 0; j < 4; ++j) { v0[j] = sigmoidf_(v0[j]); v1[j] = sigmoidf_(v1[j]); } }
                const int orow = (t == 2) ? ((row & ~4095) | lat_tok(row & 4095)) : row;
                *(uint4*)(dst + (size_t)orow * DM + ct) = pack8(v0, v1); )
        } else {
            bf16_t* dst = (u.kind == 1 ? rgxc : mlxc) + u.pn * 256;
            EPI_LOOP8( *(uint4*)(dst + (size_t)row * DM + ct) = pack8(v0, v1); )
        }
        return false;
    }
};
struct EpiBranch {
    static constexpr bool PERM = true;
    const bf16_t* sgr; const bf16_t* sgm; bf16_t* mix;
    DI bool operator()(Acc& acc, const Unit& u, int wr, int wc, int fr, int fq) const {
        if (u.kind == 0) {
            EPI_LOOP8( const size_t o = (size_t)row * DM + u.pn * 256 + ct; float a[8], b[8]; unpack8(*(const uint4*)(sgr + o), a); unpack8(*(const uint4*)(sgm + o), b);
                _Pragma("unroll") for (int j = 0; j < 4; ++j) { v0[j] *= a[j] * frcp(b[j]); v1[j] *= a[4 + j] * frcp(b[4 + j]); }
                asm volatile("" ::: "memory"); )
            return true;
        }
        EPI_LOOP8( const size_t o = (size_t)row * DM + u.pn * 256 + ct; float b[8]; unpack8(*(const uint4*)(sgm + o), b);
            f32x4 r0, r1;
            _Pragma("unroll") for (int j = 0; j < 4; ++j) { r0[j] = v0[j] * b[j]; r1[j] = v1[j] * b[4 + j]; }
            *(uint4*)(mix + o) = pack8(r0, r1); asm volatile("" ::: "memory"); )
        return false;
    }
};
struct EpiOutProj {
    static constexpr bool PERM = false;
    const float* x; const float* modl; float* x1;
    DI bool operator()(Acc& acc, const Unit& u, int wr, int wc, int fr, int fq) const {
        const float* g1 = modl + (u.pm >> 4) * NIN + 2048 + u.pn * 256;
        EPI_LOOP( const size_t o = (size_t)row * DM + u.pn * 256 + ct; const float4 g = *(const float4*)(g1 + ct), xx = *(const float4*)(x + o);
            float4 r; r.x = xx.x + g.x * v[0]; r.y = xx.y + g.y * v[1]; r.z = xx.z + g.z * v[2]; r.w = xx.w + g.w * v[3]; *(float4*)(x1 + o) = r; )
        return false;
    }
};
struct EpiFfnIn {
    static constexpr bool PERM = true;
    bf16_t* act;
    DI bool operator()(Acc& acc, const Unit& u, int wr, int wc, int fr, int fq) const {
#pragma unroll
        for (int ai = 0; ai < 2; ++ai)
#pragma unroll
            for (int m = 0; m < 4; ++m) { const int row = u.pm * 256 + ai * 128 + wr * 64 + m * 16 + fr;
                f32x4 r0, r1;
#pragma unroll
                for (int j = 0; j < 4; ++j) { r0[j] = siluf_(acc[ai][0][m][0][j]) * acc[ai][1][m][0][j]; r1[j] = siluf_(acc[ai][0][m][1][j]) * acc[ai][1][m][1][j]; }
                *(uint4*)(act + (size_t)row * DFF + u.pn * 128 + wc * 32 + fq * 8) = pack8(r0, r1); }
        return false;
    }
};
struct EpiFfnOut {
    static constexpr bool PERM = false;
    float* x12; const float* modl;
    DI bool operator()(Acc& acc, const Unit& u, int wr, int wc, int fr, int fq) const {
        const float* g2 = modl + (u.pm >> 4) * NIN + 5120 + u.pn * 256;
        EPI_LOOP( const size_t o = (size_t)row * DM + u.pn * 256 + ct; const float4 g = *(const float4*)(g2 + ct); float4 xx = *(const float4*)(x12 + o);
            xx.x += g.x * v[0]; xx.y += g.y * v[1]; xx.z += g.z * v[2]; xx.w += g.w * v[3]; *(float4*)(x12 + o) = xx; )
        return false;
    }
};

#endif
__device__ __forceinline__ void phase_rg_naive(const Params& P) {
    const int tid = threadIdx.x, wid = tid >> 6, lane = tid & 63;
    const bf16_t* rgx = (const bf16_t*)(P.ws + OFF_RGX); const bf16_t* rgxc = (const bf16_t*)(P.ws + OFF_RGXC); const bf16_t* ggelu = (const bf16_t*)(P.ws + OFF_GGELU);
    bf16_t* yrg = (bf16_t*)(P.ws + OFF_U); float* HB = P.out;
    for (int item = wid * gridDim.x + blockIdx.x; item < NB * 16; item += gridDim.x * 8) {
        const int b = item >> 4, n = item & 15, ch = n * 64 + lane;
        float cw[4];
#pragma unroll
        for (int j = 0; j < 4; ++j) cw[j] = P.rg_conv_w[j * DM + ch];
        const float cb = P.rg_conv_b[ch];
        for (int pass = 0; pass < 2; ++pass) {
            const int d = 1 - pass;
            float wa_r[64], wx_r[64];
#pragma unroll
            for (int i = 0; i < 64; ++i) { wa_r[i] = P.rg_wa[((size_t)(d * 16 + n) * 64 + i) * 64 + lane]; wx_r[i] = P.rg_wx[((size_t)(d * 16 + n) * 64 + i) * 64 + lane]; }
            const float ba = P.rg_ba[d * DM + ch], bx = P.rg_bx[d * DM + ch];
            const float cA = -8.0f * softplusf_(-P.rg_lambda[d * DM + ch]);
            float h = 0.f;
            for (int sq = 0; sq < 2; ++sq) {
                const int Ls = sq ? SEQ : CTXL;
                const bf16_t* X = sq ? rgx + (size_t)b * SEQ * DM : rgxc + (size_t)b * CTXL * DM;
                for (int s = 0; s < Ls; ++s) {
                    const int t = d ? Ls - 1 - s : s;
                    float xc = cb;
#pragma unroll
                    for (int j = 0; j < 4; ++j) { const int tt = t + j - 2; if (tt >= 0 && tt < Ls) xc += cw[j] * bf2f(X[(size_t)tt * DM + ch]); }
                    float ra = ba, ri = bx;
#pragma unroll
                    for (int i = 0; i < 64; ++i) { const float xi = __int_as_float(__builtin_amdgcn_readlane(__float_as_int(xc), i)); ra += xi * wa_r[i]; ri += xi * wx_r[i]; }
                    const float r = sigmoidf_(ra), ig = sigmoidf_(ri);
                    const float log_a = cA * r, a = expf(log_a), bb = sqrtf(-expm1f(2.0f * log_a)) * (ig * xc);
                    h = a * h + bb;
                    if (sq) {
                        const size_t o = ((size_t)b * SEQ + t) * DM + ch;
                        if (d) HB[o] = h; else yrg[o] = f2bf((h + HB[o]) * bf2f(ggelu[o]));
                    }
                }
            }
        }
    }
}

constexpr int RG_WTOT = 0, RG_XCS = 4096, RG_CWT = RG_XCS + 8 * 16 * 33 * 4, RG_LDS = RG_CWT + 64 * 8 * 4;
DI float neg_expm1(float x) {
    return x > -0.1f ? -x * (1.0f + x * (0.5f + x * (0.16666667f + x * 0.041666668f))) : 1.0f - __expf(x);
}
template <int d>
__device__ __forceinline__ void rg_pass(const Params& P, char* smem, const int b, const int n, const int half) {
    const int tid = threadIdx.x, wid = tid >> 6, lane0 = tid & 63;
    const bf16_t* rgx = (const bf16_t*)(P.ws + OFF_RGX) + (size_t)b * SEQ * DM; const bf16_t* rgxc = (const bf16_t*)(P.ws + OFF_RGXC) + (size_t)b * CTXL * DM;
    const bf16_t* ggelu = (const bf16_t*)(P.ws + OFF_GGELU) + (size_t)b * SEQ * DM; bf16_t* yrg = (bf16_t*)(P.ws + OFF_U) + (size_t)b * SEQ * DM; float* HB = P.out + (size_t)b * SEQ * DM;
    bf16x8 wfa[2][2], wfx[2][2];
    float ba[2], bx[2], cA[2];
    {
        const int fr = lane0 & 15, fq = lane0 >> 4;
#pragma unroll
        for (int ks = 0; ks < 2; ++ks)
#pragma unroll
            for (int nt = 0; nt < 2; ++nt)
#pragma unroll
                for (int j = 0; j < 8; ++j) { const size_t wi_ = ((size_t)(d * 16 + n) * 64 + 32 * ks + 8 * fq + j) * 64 + 32 * half + 16 * nt + fr;
                    wfa[ks][nt][j] = (short)f2bf(P.rg_wa[wi_]); wfx[ks][nt][j] = (short)f2bf(P.rg_wx[wi_]); }
#pragma unroll
        for (int nt = 0; nt < 2; ++nt) { const int ch = 64 * n + 32 * half + 16 * nt + fr; ba[nt] = P.rg_ba[d * DM + ch]; bx[nt] = P.rg_bx[d * DM + ch]; cA[nt] = -8.0f * softplusf_(-P.rg_lambda[d * DM + ch]); }
    }
    float hc[2] = {0.f, 0.f};
    uint4 raw[4][2];
    auto tile_geo = [&](int ti_, int& sq, int& T0, int& Ls) { sq = ti_ >= 2; const int k = sq ? ti_ - 2 : ti_, nts = sq ? 32 : 2; T0 = 128 * (d ? nts - 1 - k : k); Ls = sq ? SEQ : CTXL; };
    auto load_raw = [&](int ti_, const int lane) {
        int sq, T0, Ls; tile_geo(ti_, sq, T0, Ls);
        const int fr = lane & 15, fq = lane >> 4, tauA = 16 * wid + fr, tA = d ? T0 + 127 - tauA : T0 + tauA;
        const bf16_t* X = sq ? rgx : rgxc;
#pragma unroll
        for (int j = 0; j < 4; ++j) { const int tt = tA + j - 2; const bool ok = tt >= 0 && tt < Ls; const int tc = ok ? tt : tA;
#pragma unroll
            for (int ks = 0; ks < 2; ++ks) { uint4 v = *(const uint4*)(X + (size_t)tc * DM + 64 * n + 32 * ks + 8 * fq); if (!ok) { v.x = v.y = v.z = v.w = 0u; } raw[j][ks] = v; } }
    };
    load_raw(0, lane0);
    for (int ti_ = 0; ti_ < 34; ++ti_) {
        int lane = lane0; LAUNDER(lane);
        const int fr = lane & 15, fq = lane >> 4;
        int sq, T0, Ls; tile_geo(ti_, sq, T0, Ls);
        float hbv[2][4]; bf16_t ggv[2][4];
        if (sq && d == 0) {
#pragma unroll
            for (int nt = 0; nt < 2; ++nt)
#pragma unroll
                for (int j = 0; j < 4; ++j) { const int tau = 16 * wid + 4 * fq + j, t = T0 + tau; const size_t o = (size_t)t * DM + 64 * n + 32 * half + 16 * nt + fr; hbv[nt][j] = HB[o]; ggv[nt][j] = ggelu[o]; }
        }
        bf16x8 af[2];
        {
            const float* cwt = (const float*)(smem + RG_CWT);
            float* xcs = (float*)(smem + RG_XCS) + wid * 16 * 33;
#pragma unroll
            for (int ks = 0; ks < 2; ++ks) {
                float u[4][8];
#pragma unroll
                for (int j = 0; j < 4; ++j) { uint2 lo, hi; lo.x = raw[j][ks].x; lo.y = raw[j][ks].y; hi.x = raw[j][ks].z; hi.y = raw[j][ks].w; float a4[4], b4[4]; unpack4(lo, a4); unpack4(hi, b4);
#pragma unroll
                    for (int c = 0; c < 4; ++c) { u[j][c] = a4[c]; u[j][4 + c] = b4[c]; } }
                float xa[8];
#pragma unroll
                for (int c = 0; c < 8; ++c) { const float4 w = *(const float4*)(cwt + (32 * ks + 8 * fq + c) * 8); const float bb = cwt[(32 * ks + 8 * fq + c) * 8 + 4];
                    xa[c] = bb + w.x * u[0][c] + w.y * u[1][c] + w.z * u[2][c] + w.w * u[3][c]; }
                const uint2 p0 = pack4(xa[0], xa[1], xa[2], xa[3]), p1 = pack4(xa[4], xa[5], xa[6], xa[7]);
                uint4 pk; pk.x = p0.x; pk.y = p0.y; pk.z = p1.x; pk.w = p1.y; af[ks] = __builtin_bit_cast(bf16x8, pk);
                if (ks == half) {
#pragma unroll
                    for (int c = 0; c < 8; ++c) xcs[fr * 33 + 8 * fq + c] = xa[c];
                }
            }
        }
        if (ti_ + 1 < 34) load_raw(ti_ + 1, lane);
        f32x4 Da[2], Dx[2];
#pragma unroll
        for (int nt = 0; nt < 2; ++nt) {
            Da[nt] = __builtin_amdgcn_mfma_f32_16x16x32_bf16(af[0], wfa[0][nt], (f32x4){0.f, 0.f, 0.f, 0.f}, 0, 0, 0);
            Da[nt] = __builtin_amdgcn_mfma_f32_16x16x32_bf16(af[1], wfa[1][nt], Da[nt], 0, 0, 0);
            Dx[nt] = __builtin_amdgcn_mfma_f32_16x16x32_bf16(af[0], wfx[0][nt], (f32x4){0.f, 0.f, 0.f, 0.f}, 0, 0, 0);
            Dx[nt] = __builtin_amdgcn_mfma_f32_16x16x32_bf16(af[1], wfx[1][nt], Dx[nt], 0, 0, 0);
        }
        float av[2][4], bv[2][4], Aq[2], Bq[2];
        {
            const float* xcs = (const float*)(smem + RG_XCS) + wid * 16 * 33;
#pragma unroll
            for (int nt = 0; nt < 2; ++nt) {
                float A = 1.f, B = 0.f;
#pragma unroll
                for (int j = 0; j < 4; ++j) {
                    const float xc = xcs[(4 * fq + j) * 33 + 16 * nt + fr];
                    const float r = sigmoidf_(Da[nt][j] + ba[nt]), ig = sigmoidf_(Dx[nt][j] + bx[nt]);
                    const float log_a = cA[nt] * r, a = __expf(log_a), bb = sqrtf(neg_expm1(2.0f * log_a)) * (ig * xc);
                    av[nt][j] = a; bv[nt][j] = bb; B = a * B + bb; A *= a;
                }
                float Ap = __shfl_up(A, 16), Bp = __shfl_up(B, 16);
                if (fq >= 1) { B = A * Bp + B; A = A * Ap; }
                Ap = __shfl_up(A, 32); Bp = __shfl_up(B, 32);
                if (fq >= 2) { B = A * Bp + B; A = A * Ap; }
                Aq[nt] = A; Bq[nt] = B;
            }
        }
        float* wtot = (float*)(smem + RG_WTOT) + (ti_ & 1) * 512;
        if (fq == 3) {
#pragma unroll
            for (int nt = 0; nt < 2; ++nt) { wtot[(wid * 32 + 16 * nt + fr) * 2] = Aq[nt]; wtot[(wid * 32 + 16 * nt + fr) * 2 + 1] = Bq[nt]; }
        }
        __syncthreads();
#pragma unroll
        for (int nt = 0; nt < 2; ++nt) {
            float Ae = __shfl_up(Aq[nt], 16), Be = __shfl_up(Bq[nt], 16);
            if (fq == 0) { Ae = 1.f; Be = 0.f; }
            float h = hc[nt], hw = hc[nt];
#pragma unroll
            for (int w = 0; w < 8; ++w) { const float Aw = wtot[(w * 32 + 16 * nt + fr) * 2], Bw = wtot[(w * 32 + 16 * nt + fr) * 2 + 1]; h = Aw * h + Bw; if (w < wid) hw = h; }
            hc[nt] = h;
            float hh = Ae * hw + Be;
#pragma unroll
            for (int j = 0; j < 4; ++j) {
                hh = av[nt][j] * hh + bv[nt][j];
                if (sq) {
                    const int tau = 16 * wid + 4 * fq + j, t = d ? T0 + 127 - tau : T0 + tau; const size_t o = (size_t)t * DM + 64 * n + 32 * half + 16 * nt + fr;
                    if (d) HB[o] = hh; else yrg[o] = f2bf((hh + hbv[nt][j]) * bf2f(ggv[nt][j]));
                }
            }
        }
    }
}
__device__ __forceinline__ void phase_rg(const Params& P, char* smem) {
    for (int item = blockIdx.x; item < 256; item += gridDim.x) {
        const int half = item & 1, n = (item >> 1) & 15, b = item >> 5;
        __syncthreads();
        float* cwt = (float*)(smem + RG_CWT);
        for (int i = threadIdx.x; i < 64 * 8; i += 512) { const int ch = i >> 3, e = i & 7; cwt[i] = e < 4 ? P.rg_conv_w[e * DM + 64 * n + ch] : (e == 4 ? P.rg_conv_b[64 * n + ch] : 0.f); }
        __syncthreads();
        rg_pass<1>(P, smem, b, n, half);
        __syncthreads();
        rg_pass<0>(P, smem, b, n, half);
    }
}

DI const bf16_t* ml_row(const Params& P, int b, int sq, int pos) {
    return sq ? (const bf16_t*)(P.ws + OFF_MLX) + ((size_t)b * SEQ + pos) * DM : (const bf16_t*)(P.ws + OFF_MLXC) + ((size_t)b * CTXL + pos) * DM;
}

__device__ __forceinline__ void phase_mlstm_naive(const Params& P, char* smem) {
    float* xm_s = (float*)smem; float* u_s = xm_s + 256; float* q_s = u_s + 256; float* k_s = q_s + 256; float* v_s = k_s + 256;
    const int tid = threadIdx.x, vloc = tid >> 4, kseg = tid & 15;
    const float* logi = (const float*)(P.ws + OFF_LOGI); const float* logf_ = (const float*)(P.ws + OFF_LOGF);
    for (int item = blockIdx.x; item < NB * 4 * 2 * 8; item += gridDim.x) {
        const int vs = item & 7, d = (item >> 3) & 1, hd = (item >> 4) & 3, b = item >> 6;
        bf16_t* Hd = (bf16_t*)(P.ws + (d ? OFF_GGELU : OFF_RGX));
        float C[16], nn[16];
#pragma unroll
        for (int i = 0; i < 16; ++i) { C[i] = 0.f; nn[i] = 0.f; }
        float m = 0.f;
        float cw[4] = {0.f, 0.f, 0.f, 0.f}, cb = 0.f, wq_r[4] = {0.f, 0.f, 0.f, 0.f}, wk_r[4] = {0.f, 0.f, 0.f, 0.f};
        int cg = 0;
        if (tid < 256) { cg = 256 * hd + tid;
#pragma unroll
            for (int j = 0; j < 4; ++j) cw[j] = P.ml_conv_w[j * DM + cg];
            cb = P.ml_conv_b[cg];
#pragma unroll
            for (int i = 0; i < 4; ++i) { wq_r[i] = P.ml_wq[((cg >> 2) * 4 + i) * 4 + (cg & 3)]; wk_r[i] = P.ml_wk[((cg >> 2) * 4 + i) * 4 + (cg & 3)]; }
        } else if (tid < 288) { cg = 256 * hd + 32 * vs + (tid - 256);
#pragma unroll
            for (int i = 0; i < 4; ++i) wq_r[i] = P.ml_wv[((cg >> 2) * 4 + i) * 4 + (cg & 3)];
        }
        for (int sq = 0; sq < 2; ++sq) {
            const int Ls = sq ? SEQ : CTXL, lo = sq ? CTXL : 0;
            for (int s = 0; s < Ls; ++s) {
                const int pos = d ? Ls - 1 - s : s;
                if (tid < 256) {
                    float a = cb, ucur = 0.f;
#pragma unroll
                    for (int j = 0; j < 4; ++j) { const int pp = pos + j - 2; if (pp >= 0 && pp < Ls) { const float uv = bf2f(ml_row(P, b, sq, pp)[cg]); a += cw[j] * uv; if (j == 2) ucur = uv; } }
                    xm_s[tid] = siluf_(a); u_s[tid] = ucur;
                }
                __syncthreads();
                if (tid < 256) { const int g4 = tid & ~3; float q = 0.f, k = 0.f;
#pragma unroll
                    for (int i = 0; i < 4; ++i) { q += xm_s[g4 + i] * wq_r[i]; k += xm_s[g4 + i] * wk_r[i]; }
                    q_s[tid] = q; k_s[tid] = k * 0.0625f;
                } else if (tid < 288) { const int j = tid - 256, g4 = (32 * vs + j) & ~3; float v = 0.f;
#pragma unroll
                    for (int i = 0; i < 4; ++i) v += u_s[g4 + i] * wq_r[i];
                    v_s[j] = v; }
                __syncthreads();
                const size_t gi = ((size_t)(b * 2 + d) * 4 + hd) * LTOT + lo + pos;
                const float li = logi[gi], lf = logf_[gi];
                const float m_new = fmaxf(lf + m, li), fd = expf(lf + m - m_new), iw = expf(li - m_new);
                const float vv = v_s[vloc] * iw; float num = 0.f, den = 0.f;
#pragma unroll
                for (int kk = 0; kk < 16; ++kk) { const float kq = k_s[kseg * 16 + kk], qq = q_s[kseg * 16 + kk];
                    C[kk] = fd * C[kk] + vv * kq; nn[kk] = fd * nn[kk] + iw * kq; num += C[kk] * qq; den += nn[kk] * qq; }
#pragma unroll
                for (int o = 8; o > 0; o >>= 1) { num += __shfl_xor(num, o); den += __shfl_xor(den, o); }
                if (sq && kseg == 0) Hd[((size_t)b * SEQ + pos) * DM + 256 * hd + 32 * vs + vloc] = f2bf(num / fmaxf(fabsf(den), expf(-m_new)));
                m = m_new;
            }
        }
        __syncthreads();
    }
}

constexpr int ML_RAW = 0, ML_QS = 512, ML_KS = ML_QS + 64 * 528, ML_CS = ML_KS + 64 * 528, ML_VT = ML_CS + 80 * 528, ML_VW = ML_VT + 80 * 144, ML_SS = ML_VW + 80 * 144, ML_SC = ML_SS + 64 * 144,
              ML_SCB = 1536, ML_WT = ML_SC + 2 * ML_SCB, ML_LDS = ML_WT + (64 * 52 + 256) * 4;
typedef short s16x4 __attribute__((ext_vector_type(4)));
DI float wave_incl_sum(float v, int lane) {
#pragma unroll
    for (int o = 1; o < 64; o <<= 1) { const float t = __shfl_up(v, o); if (lane >= o) v += t; }
    return v;
}
DI float wave_incl_max(float v, int lane) {
#pragma unroll
    for (int o = 1; o < 64; o <<= 1) { const float t = __shfl_up(v, o); if (lane >= o) v = fmaxf(v, t); }
    return v;
}
struct MlChunk { int sq, P0, Ls, lo; };
DI MlChunk ml_chunk(int cidx, int d) { MlChunk c; c.sq = cidx >= 4; const int blk = c.sq ? cidx - 4 : cidx, nblk = c.sq ? 64 : 4; c.P0 = 64 * (d ? nblk - 1 - blk : blk); c.Ls = c.sq ? SEQ : CTXL; c.lo = c.sq ? CTXL : 0; return c; }

template <int d>
__device__ __forceinline__ void mlstm_item(const Params& P, char* smem, const int vq, const int hd, const int b) {
    const int tid = threadIdx.x, wid = tid >> 6, lane0 = tid & 63;
    bf16_t* Qs = (bf16_t*)(smem + ML_QS); bf16_t* Ks = (bf16_t*)(smem + ML_KS); bf16_t* Cs = (bf16_t*)(smem + ML_CS);
    bf16_t* VT = (bf16_t*)(smem + ML_VT); bf16_t* VW = (bf16_t*)(smem + ML_VW); bf16_t* Ss = (bf16_t*)(smem + ML_SS);
    const float* logi = (const float*)(P.ws + OFF_LOGI); const float* logf_ = (const float*)(P.ws + OFF_LOGF);
    const int ti = wid >> 1, pr = wid & 1;
    bf16_t* Hd = (bf16_t*)(P.ws + (d ? OFF_GGELU : OFF_RGX));
    const size_t chain = ((size_t)(b * 2 + d) * 4 + hd) * LTOT;
    __syncthreads();
    float* wt = (float*)(smem + ML_WT);
    for (int i = tid; i < 64 * 52; i += 512) { const int gg = i / 52, e = i % 52, cgg = 256 * hd + 4 * gg; float v;
        if (e < 32) { const int wi_ = (cgg >> 2) * 16 + (e & 15); v = e < 16 ? P.ml_wq[wi_] : P.ml_wk[wi_] * 0.0625f; }
        else if (e < 48) { const int j = (e - 32) >> 2, c = (e - 32) & 3; v = P.ml_conv_w[j * DM + cgg + c]; }
        else v = P.ml_conv_b[cgg + (e - 48)];
        wt[i] = v; }
    if (tid < 256) wt[64 * 52 + tid] = P.ml_wv[(((256 * hd) >> 2) + 16 * vq + (tid >> 4)) * 16 + (tid & 15)];
    f32x4 X[2][5];
#pragma unroll
    for (int x = 0; x < 2; ++x)
#pragma unroll
        for (int vi = 0; vi < 5; ++vi) X[x][vi] = (f32x4){0.f, 0.f, 0.f, 0.f};
    for (int i = tid; i < 80 * 264 / 2; i += 512) ((unsigned*)Cs)[i] = 0u;
    for (int i = tid; i < 16 * 72; i += 512) { VT[64 * 72 + i] = (i < 72) ? (bf16_t)0x3F80 : (bf16_t)0; VW[64 * 72 + i] = 0; }
    float m_run = 0.f;
    float li_n = 0.f, lf_n = 0.f;
    auto load_gates = [&](int cidx, const int lane) { const MlChunk c = ml_chunk(cidx, d); const size_t gi = chain + c.lo + c.P0 + (d ? 63 - lane : lane); li_n = logi[gi]; lf_n = logf_[gi]; };
    auto scalars = [&](int cidx, const int lane) {
        float* sc = (float*)(smem + ML_SC + (cidx & 1) * ML_SCB);
        const float li = li_n, lf = lf_n;
        if (cidx + 1 < 68) load_gates(cidx + 1, lane);
        const float bcum = wave_incl_sum(lf, lane), colv = li - bcum, pmax = wave_incl_max(colv, lane);
        const float M = fmaxf(m_run, pmax), M63 = __shfl(M, 63), bL = __shfl(bcum, 63);
        sc[lane] = M; sc[64 + lane] = colv; sc[128 + lane] = __expf(m_run - M); sc[192 + lane] = __expf(-(bcum + M)); sc[256 + lane] = __expf(colv - M63);
        if (lane == 0) sc[320] = __expf(m_run - M63);
        m_run = bL + M63;
    };
    auto dma_raw = [&](int cidx, const int lane) {
        const MlChunk c = ml_chunk(cidx, d);
#pragma unroll
        for (int it = 0; it < 5; ++it) {
            int k = wid + 8 * it; if (it == 4) { if (wid > 1) break; k = 32 + wid; }
            const int rho0 = (k == 33) ? 65 : 2 * k, rho = rho0 + (lane >> 5);
            int pp = c.P0 + rho - 2; pp = pp < 0 ? 0 : (pp >= c.Ls ? c.Ls - 1 : pp);
            const char* gp = (const char*)(ml_row(P, b, c.sq, pp) + 256 * hd) + (lane & 31) * 16;
#ifndef EMU
            __builtin_amdgcn_global_load_lds((const unsigned*)gp, (LAS unsigned*)(smem + ML_RAW + rho0 * 512), 16, 0, 0);
#else
            memcpy(smem + ML_RAW + rho0 * 512 + lane * 16, gp, 16);
#endif
        }
    };
    uint2 qh[8];
    auto fill_a = [&](int cidx, const int g) {
        const MlChunk c = ml_chunk(cidx, d);
        const float* sc = (const float*)(smem + ML_SC + (cidx & 1) * ML_SCB);
        const bool zlo = c.P0 == 0, zhi = c.P0 + 64 == c.Ls;
        float w[52];
        { const float4* wp = (const float4*)((const float*)(smem + ML_WT) + g * 52);
#pragma unroll
          for (int i = 0; i < 13; ++i) { const float4 t = wp[i]; w[4 * i] = t.x; w[4 * i + 1] = t.y; w[4 * i + 2] = t.z; w[4 * i + 3] = t.w; } }
#pragma unroll
        for (int i = 0; i < 8; ++i) {
            const int r = 8 * wid + i, s = d ? 63 - r : r;
            float u[4][4];
#pragma unroll
            for (int j = 0; j < 4; ++j) { const int rho = r + j; uint2 ww = *(const uint2*)(smem + ML_RAW + rho * 512 + 8 * g);
                if ((zlo && rho < 2) || (zhi && rho > 65)) { ww.x = 0u; ww.y = 0u; }
                unpack4(ww, u[j]); }
            float xm[4];
#pragma unroll
            for (int cc = 0; cc < 4; ++cc) xm[cc] = siluf_(w[48 + cc] + w[32 + cc] * u[0][cc] + w[36 + cc] * u[1][cc] + w[40 + cc] * u[2][cc] + w[44 + cc] * u[3][cc]);
            float q[4], k[4];
#pragma unroll
            for (int o = 0; o < 4; ++o) { q[o] = xm[0] * w[o] + xm[1] * w[4 + o] + xm[2] * w[8 + o] + xm[3] * w[12 + o];
                k[o] = xm[0] * w[16 + o] + xm[1] * w[20 + o] + xm[2] * w[24 + o] + xm[3] * w[28 + o]; }
            qh[i] = pack4(q[0], q[1], q[2], q[3]); LAUNDER(qh[i].x); LAUNDER(qh[i].y);
            *(uint2*)(Ks + s * 264 + 4 * g) = pack4(k[0], k[1], k[2], k[3]);
            if (i & 1) __builtin_amdgcn_sched_barrier(0);
        }
        {
            const int gv = tid & 15, r0 = 2 * (tid >> 4), s_lo = d ? 62 - r0 : r0;
            const float4* wvp = (const float4*)((const float*)(smem + ML_WT) + 64 * 52 + gv * 16);
            const float4 w0 = wvp[0], w1 = wvp[1], w2 = wvp[2], w3 = wvp[3];
            float ua[4], ub[4]; unpack4(*(const uint2*)(smem + ML_RAW + (r0 + 2) * 512 + 8 * (16 * vq + gv)), ua); unpack4(*(const uint2*)(smem + ML_RAW + (r0 + 3) * 512 + 8 * (16 * vq + gv)), ub);
            const float va[4] = {ua[0] * w0.x + ua[1] * w1.x + ua[2] * w2.x + ua[3] * w3.x, ua[0] * w0.y + ua[1] * w1.y + ua[2] * w2.y + ua[3] * w3.y, ua[0] * w0.z + ua[1] * w1.z + ua[2] * w2.z + ua[3] * w3.z, ua[0] * w0.w + ua[1] * w1.w + ua[2] * w2.w + ua[3] * w3.w};
            const float vb[4] = {ub[0] * w0.x + ub[1] * w1.x + ub[2] * w2.x + ub[3] * w3.x, ub[0] * w0.y + ub[1] * w1.y + ub[2] * w2.y + ub[3] * w3.y, ub[0] * w0.z + ub[1] * w1.z + ub[2] * w2.z + ub[3] * w3.z, ub[0] * w0.w + ub[1] * w1.w + ub[2] * w2.w + ub[3] * w3.w};
            const float wsl = sc[256 + s_lo], wsh = sc[256 + s_lo + 1];
#pragma unroll
            for (int o = 0; o < 4; ++o) { const float lo_ = d ? vb[o] : va[o], hi_ = d ? va[o] : vb[o];
                *(unsigned*)(VT + (4 * gv + o) * 72 + s_lo) = cvt_pk_bf16(lo_, hi_); *(unsigned*)(VW + (4 * gv + o) * 72 + s_lo) = cvt_pk_bf16(lo_ * wsl, hi_ * wsh); }
        }
        if (wid == 0) VW[64 * 72 + g] = f2bf(sc[256 + g]);
    };
    auto fill_b = [&](const int g) {
#pragma unroll
        for (int i = 0; i < 8; ++i) { const int r = 8 * wid + i, s = d ? 63 - r : r; *(uint2*)(Qs + s * 264 + 4 * g) = qh[i]; }
    };
    if (wid == 0) { load_gates(0, lane0); scalars(0, lane0); }
    dma_raw(0, lane0);
#ifndef EMU
    asm volatile("s_waitcnt vmcnt(0)" ::: "memory");
#endif
    __syncthreads();
    for (int cidx = 0; cidx < 68; ++cidx) {
        int lane = lane0; LAUNDER(lane);
        const int fr = lane & 15, fq = lane >> 4;
        const MlChunk ck = ml_chunk(cidx, d);
        const float* sc = (const float*)(smem + ML_SC + (cidx & 1) * ML_SCB);
        fill_a(cidx, lane);
        __syncthreads();
        fill_b(lane);
        __syncthreads();
        f32x4 sacc[2], qacc[3];
        sacc[0] = sacc[1] = qacc[0] = qacc[1] = qacc[2] = (f32x4){0.f, 0.f, 0.f, 0.f};
        {
            const bf16_t* qrow = Qs + (16 * ti + fr) * 264 + 8 * fq;
            const bf16_t* k0 = Ks + (32 * pr + fr) * 264 + 8 * fq; const bf16_t* k1 = k0 + 16 * 264;
            const bf16_t* c0 = Cs + (32 * pr + fr) * 264 + 8 * fq; const bf16_t* c1 = c0 + 16 * 264; const bf16_t* c4 = Cs + (64 + fr) * 264 + 8 * fq;
#pragma unroll 4
            for (int ks = 0; ks < 8; ++ks) {
                const bf16x8 a = *(const bf16x8*)(qrow + 32 * ks);
                sacc[0] = __builtin_amdgcn_mfma_f32_16x16x32_bf16(a, *(const bf16x8*)(k0 + 32 * ks), sacc[0], 0, 0, 0);
                sacc[1] = __builtin_amdgcn_mfma_f32_16x16x32_bf16(a, *(const bf16x8*)(k1 + 32 * ks), sacc[1], 0, 0, 0);
                qacc[0] = __builtin_amdgcn_mfma_f32_16x16x32_bf16(a, *(const bf16x8*)(c0 + 32 * ks), qacc[0], 0, 0, 0);
                qacc[1] = __builtin_amdgcn_mfma_f32_16x16x32_bf16(a, *(const bf16x8*)(c1 + 32 * ks), qacc[1], 0, 0, 0);
                qacc[2] = __builtin_amdgcn_mfma_f32_16x16x32_bf16(a, *(const bf16x8*)(c4 + 32 * ks), qacc[2], 0, 0, 0);
            }
        }
#pragma unroll
        for (int s2 = 0; s2 < 2; ++s2) { const int s = 32 * pr + 16 * s2 + fr; const float cv = sc[64 + s];
#pragma unroll
            for (int j = 0; j < 4; ++j) { const int t = 16 * ti + 4 * fq + j; const float w = (s <= t) ? __expf(cv - sc[t]) : 0.f; Ss[t * 72 + s] = f2bf(sacc[s2][j] * w); } }
        __syncthreads();
        if (cidx + 1 < 68) dma_raw(cidx + 1, lane);
#pragma unroll
        for (int j = 0; j < 4; ++j) { const float si_ = sc[128 + 16 * ti + 4 * fq + j]; qacc[0][j] *= si_; qacc[1][j] *= si_; qacc[2][j] *= si_; }
        {
            const bf16_t* srow = Ss + (16 * ti + fr) * 72 + 8 * fq;
            const bf16_t* v0 = VT + (32 * pr + fr) * 72 + 8 * fq; const bf16_t* v1 = v0 + 16 * 72; const bf16_t* v4 = VT + (64 + fr) * 72 + 8 * fq;
#pragma unroll
            for (int k2 = 0; k2 < 2; ++k2) {
                const bf16x8 a = *(const bf16x8*)(srow + 32 * k2);
                qacc[0] = __builtin_amdgcn_mfma_f32_16x16x32_bf16(a, *(const bf16x8*)(v0 + 32 * k2), qacc[0], 0, 0, 0);
                qacc[1] = __builtin_amdgcn_mfma_f32_16x16x32_bf16(a, *(const bf16x8*)(v1 + 32 * k2), qacc[1], 0, 0, 0);
                qacc[2] = __builtin_amdgcn_mfma_f32_16x16x32_bf16(a, *(const bf16x8*)(v4 + 32 * k2), qacc[2], 0, 0, 0);
            }
        }
        float hv0[4], hv1[4];
#pragma unroll
        for (int j = 0; j < 4; ++j) {
            const float den = __shfl(qacc[2][j], lane & 48);
            const float rdn = frcp(fmaxf(fabsf(den), sc[192 + 16 * ti + 4 * fq + j]));
            hv0[j] = qacc[0][j] * rdn; hv1[j] = qacc[1][j] * rdn;
        }
        {
            const float dec = sc[320];
#pragma unroll
            for (int x = 0; x < 2; ++x)
#pragma unroll
                for (int vi = 0; vi < 5; ++vi) X[x][vi] *= dec;
#pragma unroll
            for (int k2 = 0; k2 < 2; ++k2) {
                bf16x8 a[2];
#pragma unroll
                for (int x = 0; x < 2; ++x) {
                    const bf16_t* pa = Ks + (32 * k2 + 8 * fq + (fr >> 2)) * 264 + 16 * (2 * wid + x) + 4 * (fr & 3);
                    const s16x4 lo = __builtin_amdgcn_ds_read_tr16_b64_v4i16((LAS s16x4*)pa), hi = __builtin_amdgcn_ds_read_tr16_b64_v4i16((LAS s16x4*)(pa + 4 * 264));
                    a[x] = __builtin_shufflevector(lo, hi, 0, 1, 2, 3, 4, 5, 6, 7);
                }
#pragma unroll
                for (int vi = 0; vi < 5; ++vi) {
                    const bf16x8 bv = *(const bf16x8*)(VW + (16 * vi + fr) * 72 + 32 * k2 + 8 * fq);
                    X[0][vi] = __builtin_amdgcn_mfma_f32_16x16x32_bf16(a[0], bv, X[0][vi], 0, 0, 0);
                    X[1][vi] = __builtin_amdgcn_mfma_f32_16x16x32_bf16(a[1], bv, X[1][vi], 0, 0, 0);
                }
            }
#pragma unroll
            for (int x = 0; x < 2; ++x)
#pragma unroll
                for (int vi = 0; vi < 5; ++vi) *(uint2*)(Cs + (16 * vi + fr) * 264 + 16 * (2 * wid + x) + 4 * fq) = pack4(X[x][vi][0], X[x][vi][1], X[x][vi][2], X[x][vi][3]);
        }
        if (cidx + 1 < 68 && wid == 0) scalars(cidx + 1, lane);
#ifndef EMU
        asm volatile("s_waitcnt vmcnt(0)" ::: "memory");
#endif
        __syncthreads();
        if (ck.sq) {
#pragma unroll
            for (int j = 0; j < 4; ++j) { const int t = 16 * ti + 4 * fq + j, pos = ck.P0 + (d ? 63 - t : t);
                bf16_t* hp = Hd + ((size_t)b * SEQ + pos) * DM + 256 * hd + 64 * vq + 32 * pr + fr;
                hp[0] = f2bf(hv0[j]); hp[16] = f2bf(hv1[j]); }
        }
    }
}
__device__ __forceinline__ void phase_mlstm_chunk(const Params& P, char* smem) {
    for (int item = blockIdx.x; item < 256; item += gridDim.x) {
        const int slot = item >> 3, chainid = (item & 7) * 8 + (slot >> 2), vq = slot & 3, d = chainid & 1, hd = (chainid >> 1) & 3, b = chainid >> 3;
        if (d) mlstm_item<1>(P, smem, vq, hd, b); else mlstm_item<0>(P, smem, vq, hd, b);
    }
}

constexpr int PRE_CWT = 0, PRE_QKV = 1024 * 8 * 4, PRE_LDS = PRE_QKV + 256 * 48 * 4;
__device__ __forceinline__ void phase_mlpre(const Params& P, char* smem) {
    const int tid = threadIdx.x, wid = tid >> 6, lane0 = tid & 63;
    float* cwt = (float*)(smem + PRE_CWT);
    float* qkv = (float*)(smem + PRE_QKV);
    __syncthreads();
    for (int i = tid; i < 1024 * 8; i += 512) { const int ch = i >> 3, e = i & 7; cwt[i] = e < 4 ? P.ml_conv_w[e * DM + ch] : (e == 4 ? P.ml_conv_b[ch] : 0.f); }
    for (int i = tid; i < 256 * 48; i += 512) { const int g = i / 48, e = i % 48, which = e >> 4, wi_ = g * 16 + (e & 15); qkv[i] = which == 0 ? P.ml_wq[wi_] : which == 1 ? P.ml_wk[wi_] * 0.0625f : P.ml_wv[wi_]; }
    __syncthreads();
    const bf16_t* WG = (const bf16_t*)(P.ws + OFF_WG);
    float* logi = (float*)(P.ws + OFF_LOGI); float* logf_ = (float*)(P.ws + OFF_LOGF);
    for (int tile = wid * gridDim.x + blockIdx.x; tile < NB * 272; tile += 8 * gridDim.x) {
        const int b = tile / 272, r = tile % 272, sq = r >= 16, pos0 = sq ? (r - 16) * 16 : r * 16, Ls = sq ? SEQ : CTXL, pidx0 = sq ? CTXL + pos0 : pos0;
        f32x4 acc = (f32x4){0.f, 0.f, 0.f, 0.f};
        const bf16_t* rowp[4]; bool ok[4];
        {
            const int pos = pos0 + (lane0 & 15);
#pragma unroll
            for (int j = 0; j < 4; ++j) { const int pp = pos + j - 2; ok[j] = pp >= 0 && pp < Ls; rowp[j] = ml_row(P, b, sq, ok[j] ? pp : pos); }
        }
        uint4 nxt[4];
#pragma unroll
        for (int j = 0; j < 4; ++j) { nxt[j] = *(const uint4*)(rowp[j] + 8 * (lane0 >> 4)); if (!ok[j]) nxt[j].x = nxt[j].y = nxt[j].z = nxt[j].w = 0u; }
        for (int ks = 0; ks < 32; ++ks) {
            int lane = lane0; LAUNDER(lane);
            const int fq = lane >> 4, c0 = 32 * ks + 8 * fq;
            uint4 cur[4];
#pragma unroll
            for (int j = 0; j < 4; ++j) cur[j] = nxt[j];
            if (ks + 1 < 32) {
#pragma unroll
                for (int j = 0; j < 4; ++j) { nxt[j] = *(const uint4*)(rowp[j] + 32 * (ks + 1) + 8 * fq); if (!ok[j]) nxt[j].x = nxt[j].y = nxt[j].z = nxt[j].w = 0u; }
            }
            float u[4][8];
#pragma unroll
            for (int j = 0; j < 4; ++j) { uint2 lo, hi; lo.x = cur[j].x; lo.y = cur[j].y; hi.x = cur[j].z; hi.y = cur[j].w; float a4[4], b4[4]; unpack4(lo, a4); unpack4(hi, b4);
#pragma unroll
                for (int c = 0; c < 4; ++c) { u[j][c] = a4[c]; u[j][4 + c] = b4[c]; } }
            float xm[8];
#pragma unroll
            for (int c = 0; c < 8; ++c) { const float4 w = *(const float4*)(cwt + (c0 + c) * 8); const float bb = cwt[(c0 + c) * 8 + 4];
                xm[c] = siluf_(bb + w.x * u[0][c] + w.y * u[1][c] + w.z * u[2][c] + w.w * u[3][c]); }
            float q[8], k[8], v[8];
#pragma unroll
            for (int gi = 0; gi < 2; ++gi) { const float* wg = qkv + ((c0 >> 2) + gi) * 48;
#pragma unroll
                for (int o = 0; o < 4; ++o) {
                    q[4 * gi + o] = xm[4 * gi] * wg[o] + xm[4 * gi + 1] * wg[4 + o] + xm[4 * gi + 2] * wg[8 + o] + xm[4 * gi + 3] * wg[12 + o];
                    k[4 * gi + o] = xm[4 * gi] * wg[16 + o] + xm[4 * gi + 1] * wg[20 + o] + xm[4 * gi + 2] * wg[24 + o] + xm[4 * gi + 3] * wg[28 + o];
                    v[4 * gi + o] = u[2][4 * gi] * wg[32 + o] + u[2][4 * gi + 1] * wg[36 + o] + u[2][4 * gi + 2] * wg[40 + o] + u[2][4 * gi + 3] * wg[44 + o]; } }
            uint4 pq, pk, pv; { const uint2 a = pack4(q[0], q[1], q[2], q[3]), c = pack4(q[4], q[5], q[6], q[7]); pq.x = a.x; pq.y = a.y; pq.z = c.x; pq.w = c.y; }
            { const uint2 a = pack4(k[0], k[1], k[2], k[3]), c = pack4(k[4], k[5], k[6], k[7]); pk.x = a.x; pk.y = a.y; pk.z = c.x; pk.w = c.y; }
            { const uint2 a = pack4(v[0], v[1], v[2], v[3]), c = pack4(v[4], v[5], v[6], v[7]); pv.x = a.x; pv.y = a.y; pv.z = c.x; pv.w = c.y; }
            const bf16x8 bq = *(const bf16x8*)(WG + ((size_t)(0 * 32 + ks) * 64 + lane) * 8), bk = *(const bf16x8*)(WG + ((size_t)(1 * 32 + ks) * 64 + lane) * 8), bvv = *(const bf16x8*)(WG + ((size_t)(2 * 32 + ks) * 64 + lane) * 8);
            acc = __builtin_amdgcn_mfma_f32_16x16x32_bf16(__builtin_bit_cast(bf16x8, pq), bq, acc, 0, 0, 0);
            acc = __builtin_amdgcn_mfma_f32_16x16x32_bf16(__builtin_bit_cast(bf16x8, pk), bk, acc, 0, 0, 0);
            acc = __builtin_amdgcn_mfma_f32_16x16x32_bf16(__builtin_bit_cast(bf16x8, pv), bvv, acc, 0, 0, 0);
        }
        {
            const int fr = lane0 & 15, fq = lane0 >> 4, type = fr >> 3, dd = (fr >> 2) & 1, hh = fr & 3;
            const float bias = (type ? P.ml_bf : P.ml_bi)[dd * 4 + hh];
            float4 o; float* ov = (float*)&o;
#pragma unroll
            for (int j = 0; j < 4; ++j) { const float pre = acc[j] + bias; ov[j] = type ? -softplusf_(-pre) : pre; }
            *(float4*)((type ? logf_ : logi) + ((size_t)(b * 2 + dd) * 4 + hh) * LTOT + pidx0 + 4 * fq) = o;
        }
    }
    __syncthreads();
}

__device__ __forceinline__ void phase_yml(const Params& P) {
    const int lane = threadIdx.x & 63, gw = (blockIdx.x * blockDim.x + threadIdx.x) >> 6, nw = (gridDim.x * blockDim.x) >> 6;
    const bf16_t* hf = (const bf16_t*)(P.ws + OFF_RGX); const bf16_t* hb = (const bf16_t*)(P.ws + OFF_GGELU); const bf16_t* smlo = (const bf16_t*)(P.ws + OFF_SMLO);
    bf16_t* yml = (bf16_t*)P.out;
    for (int idx = gw; idx < NB * SEQ; idx += nw) {
        const int b = idx >> 12, p = idx & 4095, t = lat_tok(p);
        const size_t hrow = ((size_t)b * SEQ + p) * DM, orow = ((size_t)b * SEQ + t) * DM;
        uint2 outw[4];
#pragma unroll
        for (int i = 0; i < 4; ++i) {
            const int c0 = 256 * i + 4 * lane;
            float a[4], bb[4], hv[4];
            unpack4(*(const uint2*)(hf + hrow + c0), a); unpack4(*(const uint2*)(hb + hrow + c0), bb);
#pragma unroll
            for (int j = 0; j < 4; ++j) hv[j] = a[j] + bb[j];
            const float mu = wave_sum(hv[0] + hv[1] + hv[2] + hv[3]) * (1.0f / 256.0f);
            float dv[4], q = 0.f;
#pragma unroll
            for (int j = 0; j < 4; ++j) { dv[j] = hv[j] - mu; q += dv[j] * dv[j]; }
            const float rs = rsqrtf(wave_sum(q) * (1.0f / 256.0f) + EPS);
            float acc[4];
#pragma unroll
            for (int j = 0; j < 4; ++j) acc[j] = P.ml_conv_b[c0 + j];
#pragma unroll
            for (int jj = 0; jj < 4; ++jj) { const int pp = p + jj - 2; if (pp >= 0 && pp < SEQ) { float uv[4]; unpack4(*(const uint2*)(ml_row(P, b, 1, pp) + c0), uv);
#pragma unroll
                for (int j = 0; j < 4; ++j) acc[j] += P.ml_conv_w[jj * DM + c0 + j] * uv[j]; } }
            float sg[4]; unpack4(*(const uint2*)(smlo + orow + c0), sg);
            float y[4];
#pragma unroll
            for (int j = 0; j < 4; ++j) y[j] = (dv[j] * rs * P.ml_norm_g[c0 + j] + P.ml_skip[c0 + j] * siluf_(acc[j])) * sg[j];
            outw[i] = pack4(y[0], y[1], y[2], y[3]);
        }
#pragma unroll
        for (int i = 0; i < 4; ++i) *(uint2*)(yml + orow + 256 * i + 4 * lane) = outw[i];
    }
}

#ifndef EMU
static_assert(PRE_LDS <= ML_LDS && RG_LDS <= ML_LDS, "LDS");
constexpr int SMEM_BYTES = ML_LDS > GEMM_LDS ? ML_LDS : GEMM_LDS;
__global__ void __launch_bounds__(512) fwd_mega(Params P) {
    extern __shared__ __attribute__((aligned(16))) unsigned char dyn_lds[];
    char* smem = (char*)dyn_lds;
    LAS unsigned char* lds = (LAS unsigned char*)dyn_lds;
    cg::grid_group grid = cg::this_grid();
    char* ws = P.ws;
    const int G = gridDim.x, c = blockIdx.x;
    const float* modl = (const float*)(ws + OFF_MODL);
    phase_prep(P, smem);
    grid.sync();
    phase_u(P);
    grid.sync();
    { SchedInProj s{ws + OFF_U, ws + OFF_UC, ws + OFF_WINT, G, c}; EpiInProj e{(bf16_t*)(ws + OFF_RGX), (bf16_t*)(ws + OFF_RGXC), (bf16_t*)(ws + OFF_MLXC)}; gemm8(lds, DM, s, e); }
    grid.sync();
    phase_rg(P, smem);
    phase_mlpre(P, smem);
    grid.sync();
    phase_mlstm_chunk(P, smem);
    grid.sync();
    phase_yml(P);
    grid.sync();
    { SchedBranch s{ws + OFF_U, ws + OFF_WBRG, (const char*)P.out, ws + OFF_WBML, G, c}; EpiBranch e{(const bf16_t*)(ws + OFF_SGR), (const bf16_t*)(ws + OFF_SGM), (bf16_t*)(ws + OFF_MLX)}; gemm8(lds, DM, s, e); }
    grid.sync();
    { SchedPlain s{ws + OFF_MLX, ws + OFF_WOUT, 128, 4, G, c, TSTEP1024}; EpiOutProj e{P.x, modl, P.out}; gemm8(lds, DM, s, e); }
    grid.sync();
    phase_h2(P);
    grid.sync();
    { SchedPlain s{ws + OFF_U, ws + OFF_FFNIN, 128, 22, G, c, TSTEP1024}; EpiFfnIn e{(bf16_t*)(ws + OFF_RGX)}; gemm8(lds, DM, s, e); }
    grid.sync();
    { SchedPlain s{ws + OFF_RGX, ws + OFF_FFNOUT, 128, 4, G, c, TSTEP_FF}; EpiFfnOut e{P.out, modl}; gemm8(lds, DFF, s, e); }
    grid.sync();
    phase_final(P);
}

extern "C" void kernel_launch(void* const* d_in, const int* in_sizes, int n_in, void* d_out, int out_size, void* d_ws, size_t ws_size, hipStream_t stream) {
    (void)in_sizes; (void)n_in; (void)out_size;
    if (ws_size < WS_TOTAL) { fprintf(stderr, "workspace too small: %zu < %zu\n", ws_size, (size_t)WS_TOTAL); return; }
    static int grid_blocks = 0;
    if (!grid_blocks) {
        int dev = 0, cus = 0, per_cu = 0;
        (void)hipGetDevice(&dev);
        (void)hipDeviceGetAttribute(&cus, hipDeviceAttributeMultiprocessorCount, dev);
        if (hipFuncSetAttribute((const void*)fwd_mega, hipFuncAttributeMaxDynamicSharedMemorySize, SMEM_BYTES) != hipSuccess) fprintf(stderr, "hipFuncSetAttribute failed\n");
        (void)hipOccupancyMaxActiveBlocksPerMultiprocessor(&per_cu, fwd_mega, 512, SMEM_BYTES);
        if (per_cu < 1) fprintf(stderr, "occupancy query reports %d blocks per CU\n", per_cu);
        grid_blocks = cus;
    }
    Params P{};
    const float** pp = (const float**)&P;
    for (int i = 0; i < 33; ++i) pp[i] = (const float*)d_in[i];
    P.out = (float*)d_out; P.ws = (char*)d_ws;
    void* args[] = {&P};
    hipError_t e = hipLaunchCooperativeKernel((void*)fwd_mega, dim3(grid_blocks), dim3(512), args, SMEM_BYTES, stream);
    if (e != hipSuccess) fprintf(stderr, "cooperative launch failed: %s (grid %d)\n", hipGetErrorString(e), grid_blocks);
}
#endif
```

```cpp
#ifndef EMU
#include <hip/hip_runtime.h>
#include <hip/hip_cooperative_groups.h>
namespace cg = cooperative_groups;
#include <cstdio>
#include <cstdint>
#define LAS __attribute__((address_space(3)))
#else
#define LAS
#endif

typedef unsigned short bf16_t;
typedef short bf16x8 __attribute__((ext_vector_type(8)));
typedef float f32x4 __attribute__((ext_vector_type(4)));

#define DI __device__ __forceinline__

constexpr int NB = 8, SEQ = 4096, DM = 1024, CTXL = 256, MROWS = NB * SEQ, MCTX = NB * CTXL, DFF = 2816, NIN = 6144, LTOT = SEQ + CTXL;
constexpr float EPS = 1e-6f;

constexpr size_t SZ_ACT = (size_t)MROWS * DM * 2;
constexpr size_t SZ_ACTC = (size_t)MCTX * DM * 2;
constexpr size_t OFF_WINT = 0;
constexpr size_t OFF_WBRG = OFF_WINT + (size_t)NIN * DM * 2;
constexpr size_t OFF_WBML = OFF_WBRG + (size_t)DM * DM * 2;
constexpr size_t OFF_WOUT = OFF_WBML + (size_t)DM * DM * 2;
constexpr size_t OFF_FFNIN = OFF_WOUT + (size_t)DM * DM * 2;
constexpr size_t OFF_FFNOUT = OFF_FFNIN + (size_t)2 * DFF * DM * 2;
constexpr size_t OFF_MODL = OFF_FFNOUT + (size_t)DM * DFF * 2;
constexpr size_t OFF_MODC = OFF_MODL + (size_t)NB * NIN * 4;
constexpr size_t OFF_LOGI = OFF_MODC + (size_t)NIN * 4;
constexpr size_t OFF_LOGF = OFF_LOGI + (size_t)NB * 2 * 4 * LTOT * 4;
constexpr size_t OFF_U = OFF_LOGF + (size_t)NB * 2 * 4 * LTOT * 4;
constexpr size_t OFF_UC = OFF_U + SZ_ACT;
constexpr size_t OFF_RGX = OFF_UC + SZ_ACTC;
constexpr size_t OFF_GGELU = OFF_RGX + SZ_ACT;
constexpr size_t OFF_MLX = OFF_GGELU + SZ_ACT;
constexpr size_t OFF_SMLO = OFF_MLX + SZ_ACT;
constexpr size_t OFF_SGR = OFF_SMLO + SZ_ACT;
constexpr size_t OFF_SGM = OFF_SGR + SZ_ACT;
constexpr size_t OFF_RGXC = OFF_SGM + SZ_ACT;
constexpr size_t OFF_MLXC = OFF_RGXC + SZ_ACTC;
constexpr size_t OFF_WG = OFF_MLXC + SZ_ACTC;
constexpr size_t OFF_BAR = OFF_WG + (size_t)3 * 32 * 64 * 8 * 2;
constexpr size_t WS_TOTAL = OFF_BAR + 3456 * 4;

struct Params {
    const float *x, *c, *ctx, *c_ctx, *w_mod, *b_mod, *norm1_g, *norm2_g, *w_in, *rg_conv_w, *rg_conv_b, *rg_wa, *rg_ba, *rg_wx, *rg_bx,
        *rg_lambda, *ml_conv_w, *ml_conv_b, *ml_wq, *ml_wk, *ml_wv, *ml_wi, *ml_bi, *ml_wf, *ml_bf, *ml_norm_g, *ml_skip, *w_branch_rg,
        *w_branch_ml, *w_out, *w_ffn_in, *w_ffn_out, *final_norm_g;
    float* out;
    char* ws;
};

DI bf16_t f2bf(float x) { unsigned u = __float_as_uint(x); u += 0x7fffu + ((u >> 16) & 1u); return (bf16_t)(u >> 16); }
DI float bf2f(bf16_t b) { return __uint_as_float(((unsigned)b) << 16); }
#ifndef EMU
#define LAUNDER(p) asm volatile("" : "+v"(p))
#else
#define LAUNDER(p)
#endif
#ifndef EMU
DI float frcp(float x) { return __builtin_amdgcn_rcpf(x); }
#else
DI float frcp(float x) { return 1.0f / x; }
#endif
DI float sigmoidf_(float x) { return frcp(1.0f + __expf(-x)); }
DI float siluf_(float x) { return x * sigmoidf_(x); }
DI float gelu_tanh(float x) { const float u2 = 1.5957691216057308f * (x + 0.044715f * x * x * x); return x * sigmoidf_(u2); }
DI float softplusf_(float x) { return fmaxf(x, 0.f) + log1pf(expf(-fabsf(x))); }
DI float wave_sum(float v) {
#pragma unroll
    for (int o = 32; o > 0; o >>= 1) v += __shfl_xor(v, o);
    return v;
}
DI void unpack4(uint2 w, float (&f)[4]) {
    f[0] = __uint_as_float(w.x << 16); f[1] = __uint_as_float(w.x & 0xffff0000u);
    f[2] = __uint_as_float(w.y << 16); f[3] = __uint_as_float(w.y & 0xffff0000u);
}
#ifndef EMU
typedef __bf16 bf16x2_n __attribute__((ext_vector_type(2)));
typedef float f32x2_n __attribute__((ext_vector_type(2)));
DI unsigned cvt_pk_bf16(float lo, float hi) { const f32x2_n v = {lo, hi}; return __builtin_bit_cast(unsigned, __builtin_convertvector(v, bf16x2_n)); }
#else
DI unsigned cvt_pk_bf16(float lo, float hi) { return (unsigned)f2bf(lo) | ((unsigned)f2bf(hi) << 16); }
#endif
DI uint2 pack4(float a, float b, float c, float d) { uint2 w; w.x = cvt_pk_bf16(a, b); w.y = cvt_pk_bf16(c, d); return w; }
DI int lat_tok(int p) { return (p & 63) * 64 + (p >> 6); }

DI void tr_unit(float* tile  , const float* src, int ldsrc, int k0, int n0src, bf16_t* dst, int lddst, int r0dst) {
    const int tid = threadIdx.x;
#pragma unroll
    for (int i = 0; i < 2; ++i) {
        const int k = (tid >> 4) + 32 * i, n4 = (tid & 15) * 4;
        const float4 v = *(const float4*)(src + (size_t)(k0 + k) * ldsrc + n0src + n4);
        tile[k * 65 + n4 + 0] = v.x; tile[k * 65 + n4 + 1] = v.y; tile[k * 65 + n4 + 2] = v.z; tile[k * 65 + n4 + 3] = v.w;
    }
    __syncthreads();
    {
        const int n = tid >> 3, k8 = (tid & 7) * 8;
        float f[8];
#pragma unroll
        for (int j = 0; j < 8; ++j) f[j] = tile[(k8 + j) * 65 + n];
        uint4 w; const uint2 a = pack4(f[0], f[1], f[2], f[3]), b = pack4(f[4], f[5], f[6], f[7]);
        w.x = a.x; w.y = a.y; w.z = b.x; w.w = b.y;
        *(uint4*)(dst + (size_t)(r0dst + n) * lddst + k0 + k8) = w;
    }
    __syncthreads();
}

constexpr int PREP_T0 = 96 * 16;
constexpr int PREP_T1 = PREP_T0 + 3 * 256;
constexpr int PREP_T2 = PREP_T1 + 88 * 16;
constexpr int PREP_T3 = PREP_T2 + 16 * 44;
constexpr int PREP_T4 = PREP_T3 + 96;
constexpr int PREP_UNITS = PREP_T4 + 96;

__device__ __forceinline__ void phase_prep(const Params& P, char* smem) {
    const int tid = threadIdx.x;
    for (int u = blockIdx.x; u < PREP_UNITS; u += gridDim.x) {
        if (u < PREP_T0) {
            const int nt = u >> 4, kt = u & 15;
            tr_unit((float*)smem, P.w_in, NIN, kt * 64, nt * 64, (bf16_t*)(P.ws + OFF_WINT), DM, nt * 64);
        } else if (u < PREP_T1) {
            const int v = u - PREP_T0, which = v >> 8, w = v & 255, nt = w >> 4, kt = w & 15;
            const float* src = which == 0 ? P.w_branch_rg : which == 1 ? P.w_branch_ml : P.w_out;
            bf16_t* dst = (bf16_t*)(P.ws + (which == 0 ? OFF_WBRG : which == 1 ? OFF_WBML : OFF_WOUT));
            tr_unit((float*)smem, src, DM, kt * 64, nt * 64, dst, DM, nt * 64);
        } else if (u < PREP_T2) {
            const int v = u - PREP_T1, rt = v >> 4, kt = v & 15, R0 = rt * 64, pn = R0 >> 8, rr = R0 & 255;
            const int n0 = rr < 128 ? 128 * pn + rr : DFF + 128 * pn + (rr - 128);
            tr_unit((float*)smem, P.w_ffn_in, 2 * DFF, kt * 64, n0, (bf16_t*)(P.ws + OFF_FFNIN), DM, R0);
        } else if (u < PREP_T3) {
            const int v = u - PREP_T2, nt = v / 44, kt = v % 44;
            tr_unit((float*)smem, P.w_ffn_out, DM, kt * 64, nt * 64, (bf16_t*)(P.ws + OFF_FFNOUT), DFF, nt * 64);
        } else if (u >= PREP_T4) {
            const int e = (u - PREP_T4) * 512 + tid, j = e & 7, ln = (e >> 3) & 63, ks = (e >> 9) & 31, part = e >> 14;
            const int c = 32 * ks + 8 * (ln >> 4) + j, gt = ln & 15, type = gt >> 3, dd = (gt >> 2) & 1, hh = gt & 3;
            ((bf16_t*)(P.ws + OFF_WG))[e] = f2bf((type ? P.ml_wf : P.ml_wi)[((size_t)dd * 3072 + part * 1024 + c) * 4 + hh]);
        } else {
            const int j0 = (u - PREP_T3) * 64, wid = tid >> 6, lane = tid & 63;
            float* s = (float*)smem;
            float* red = s + 9 * 1024;
            for (int i = tid; i < 9 * 1024; i += 512) { const int r = i >> 10, k = i & 1023; const float cv = r < 8 ? P.c[r * 1024 + k] : P.c_ctx[k]; s[i] = siluf_(cv); }
            __syncthreads();
            float acc[9];
#pragma unroll
            for (int r = 0; r < 9; ++r) acc[r] = 0.f;
            for (int kk = 0; kk < 128; ++kk) {
                const int k = wid * 128 + kk; const float w = P.w_mod[(size_t)k * NIN + j0 + lane];
#pragma unroll
                for (int r = 0; r < 9; ++r) acc[r] += s[r * 1024 + k] * w;
            }
#pragma unroll
            for (int r = 0; r < 9; ++r) red[(wid * 9 + r) * 64 + lane] = acc[r];
            __syncthreads();
            for (int i = tid; i < 9 * 64; i += 512) {
                const int r = i >> 6, l = i & 63; float t = 0.f;
#pragma unroll
                for (int w = 0; w < 8; ++w) t += red[(w * 9 + r) * 64 + l];
                t += P.b_mod[j0 + l];
                if (r < 8) ((float*)(P.ws + OFF_MODL))[r * NIN + j0 + l] = t; else ((float*)(P.ws + OFF_MODC))[j0 + l] = t;
            }
            __syncthreads();
        }
    }
}

DI void row_modnorm(const float* xr, const float* g, const float* sh, const float* sc, bf16_t* outr, int lane) {
    float4 v[4]; float ss = 0.f;
#pragma unroll
    for (int i = 0; i < 4; ++i) { v[i] = *(const float4*)(xr + i * 256 + lane * 4); ss += v[i].x * v[i].x + v[i].y * v[i].y + v[i].z * v[i].z + v[i].w * v[i].w; }
    ss = wave_sum(ss);
    const float rs = rsqrtf(ss * (1.0f / 1024.0f) + EPS);
#pragma unroll
    for (int i = 0; i < 4; ++i) {
        const int c = i * 256 + lane * 4;
        const float4 gg = *(const float4*)(g + c), s1 = *(const float4*)(sc + c), s0 = *(const float4*)(sh + c);
        const float a = (v[i].x * rs * gg.x) * (1.f + s1.x) + s0.x, b = (v[i].y * rs * gg.y) * (1.f + s1.y) + s0.y;
        const float cc = (v[i].z * rs * gg.z) * (1.f + s1.z) + s0.z, d = (v[i].w * rs * gg.w) * (1.f + s1.w) + s0.w;
        *(uint2*)(outr + c) = pack4(a, b, cc, d);
    }
}
__device__ __forceinline__ void phase_u(const Params& P) {
    const int lane = threadIdx.x & 63, gw = (blockIdx.x * blockDim.x + threadIdx.x) >> 6, nw = (gridDim.x * blockDim.x) >> 6;
    const float* modl = (const float*)(P.ws + OFF_MODL); const float* modc = (const float*)(P.ws + OFF_MODC);
    for (int r = gw; r < MROWS + MCTX; r += nw) {
        if (r < MROWS) { const int b = r >> 12; row_modnorm(P.x + (size_t)r * DM, P.norm1_g, modl + b * NIN, modl + b * NIN + 1024, (bf16_t*)(P.ws + OFF_U) + (size_t)r * DM, lane); }
        else { const int rc = r - MROWS; row_modnorm(P.ctx + (size_t)rc * DM, P.norm1_g, modc, modc + 1024, (bf16_t*)(P.ws + OFF_UC) + (size_t)rc * DM, lane); }
    }
}
__device__ __forceinline__ void phase_h2(const Params& P) {
    const int lane = threadIdx.x & 63, gw = (blockIdx.x * blockDim.x + threadIdx.x) >> 6, nw = (gridDim.x * blockDim.x) >> 6;
    const float* modl = (const float*)(P.ws + OFF_MODL);
    for (int r = gw; r < MROWS; r += nw) { const int b = r >> 12; row_modnorm(P.out + (size_t)r * DM, P.norm2_g, modl + b * NIN + 3072, modl + b * NIN + 4096, (bf16_t*)(P.ws + OFF_U) + (size_t)r * DM, lane); }
}
__device__ __forceinline__ void phase_final(const Params& P) {
    const int lane = threadIdx.x & 63, gw = (blockIdx.x * blockDim.x + threadIdx.x) >> 6, nw = (gridDim.x * blockDim.x) >> 6;
    for (int r = gw; r < MROWS; r += nw) {
        float* xr = P.out + (size_t)r * DM; float4 v[4]; float ss = 0.f;
#pragma unroll
        for (int i = 0; i < 4; ++i) { v[i] = *(const float4*)(xr + i * 256 + lane * 4); ss += v[i].x * v[i].x + v[i].y * v[i].y + v[i].z * v[i].z + v[i].w * v[i].w; }
        ss = wave_sum(ss);
        const float rs = rsqrtf(ss * (1.0f / 1024.0f) + EPS);
#pragma unroll
        for (int i = 0; i < 4; ++i) { const int c = i * 256 + lane * 4; const float4 gg = *(const float4*)(P.final_norm_g + c);
            float4 o; o.x = v[i].x * rs * gg.x; o.y = v[i].y * rs * gg.y; o.z = v[i].z * rs * gg.z; o.w = v[i].w * rs * gg.w; *(float4*)(xr + c) = o; }
    }
}

#ifndef EMU
constexpr int G_BK = 64, G_HALF = 128, G_HTB = G_HALF * G_BK * 2, GEMM_LDS = 8 * G_HTB;
DI int lds_byte(int r, int c) { const int st = (r >> 4) * 2 + (c >> 5), rr = r & 15, cc = c & 31, ob = rr * 64 + cc * 2; return st * 1024 + (ob ^ (((ob >> 9) & 1) << 5)); }
DI void stage_rc(int b, int& R, int& C) { const int st = b / 1024, sb = b % 1024, swz = sb ^ (((sb >> 9) & 1) << 5); R = (st >> 1) * 16 + swz / 64; C = (st & 1) * 32 + (swz % 64) / 2; }
struct Unit { const char* A; const char* B; int pm, pn, kind; };
DI void static_order(int L, int nM, int nN, int& pm, int& pn) {
    const int q = (nM * nN) >> 3, wgid = (L & 7) * q + (L >> 3), nig = 8 * nN, gid = wgid / nig, w = wgid % nig;
    pm = gid * 8 + (w & 7); pn = w >> 3;
}
typedef f32x4 Acc[2][2][4][2];

DI int perm32(int rho) { const int n = rho >> 4, i = rho & 15; return 8 * (i >> 2) + 4 * n + (i & 3); }
template <class Sched, class Epi>
__device__ __forceinline__ void gemm8(LAS unsigned char* lds, const int K, const Sched& S, const Epi& E) {
    int tid = threadIdx.x; LAUNDER(tid);
    const int wid = __builtin_amdgcn_readfirstlane(tid >> 6), lane = tid & 63, wr = wid >> 2, wc = wid & 3, fr = lane & 15, fq = lane >> 4;
    const int nt = K / G_BK;
    unsigned voffA[2], voffB[2];
#pragma unroll
    for (int i = 0; i < 2; ++i) { int R, C; stage_rc(tid * 16 + i * 8192, R, C); const int Rb = Epi::PERM ? ((R & ~31) + perm32(R & 31)) : R;
        voffA[i] = (unsigned)(R * K + C) * 2u; voffB[i] = (unsigned)(Rb * K + C) * 2u; }
    const size_t kstep = (size_t)(G_BK * 2), hstep = (size_t)G_HALF * K * 2;
    const unsigned ldsw = (unsigned)wid * 1024u;
    const int aoff = lds_byte(wr * 64 + fr, fq * 8), boff = lds_byte(wc * 32 + fr, fq * 8);
#define G_SA(b, h) (((b) * 2 + (h)) * G_HTB)
#define G_SB(b, h) ((4 + (b) * 2 + (h)) * G_HTB)
#define G_STAGE(bufoff, gbase, voff) do { _Pragma("unroll") for (int _i = 0; _i < 2; ++_i) \
        __builtin_amdgcn_global_load_lds((const unsigned*)((const char*)(gbase) + (voff)[_i]), (LAS unsigned*)(lds + (bufoff) + ldsw + _i * 8192), 16, 0, 0); } while (0)
#define G_LDA(dst, b, h) do { _Pragma("unroll") for (int m = 0; m < 4; ++m) _Pragma("unroll") for (int k = 0; k < 2; ++k) dst[m][k] = *(const LAS bf16x8*)(lds + G_SA(b, h) + aoff + m * 2048 + k * 1024); } while (0)
#define G_LDB(dst, b, h) do { _Pragma("unroll") for (int n = 0; n < 2; ++n) _Pragma("unroll") for (int k = 0; k < 2; ++k) dst[n][k] = *(const LAS bf16x8*)(lds + G_SB(b, h) + boff + n * 2048 + k * 1024); } while (0)
#define G_MMA(ai, bj, At, Bt) do { __builtin_amdgcn_s_setprio(1); _Pragma("unroll") for (int m = 0; m < 4; ++m) _Pragma("unroll") for (int n = 0; n < 2; ++n) _Pragma("unroll") for (int k = 0; k < 2; ++k) \
        acc[ai][bj][m][n] = __builtin_amdgcn_mfma_f32_16x16x32_bf16(Bt[n][k], At[m][k], acc[ai][bj][m][n], 0, 0, 0); __builtin_amdgcn_s_setprio(0); } while (0)
#define G_WAIT_V(n) asm volatile("s_waitcnt vmcnt(" #n ")" ::: "memory")
#define G_WAIT_L(n) asm volatile("s_waitcnt lgkmcnt(" #n ")" ::: "memory")
#define G_BAR __builtin_amdgcn_s_barrier()
#define G_SCHED __builtin_amdgcn_sched_barrier(0)
#define G_ZERO() do { _Pragma("unroll") for (int a = 0; a < 2; ++a) _Pragma("unroll") for (int b = 0; b < 2; ++b) _Pragma("unroll") for (int m = 0; m < 4; ++m) _Pragma("unroll") for (int n = 0; n < 2; ++n) acc[a][b][m][n] = (f32x4){0.f, 0.f, 0.f, 0.f}; } while (0)
    Unit cur, nxt; int ui = 0;
    if (!S.next(0, cur)) return;
    Acc acc;
    G_ZERO();
    bf16x8 At[4][2], B0[2][2], B1[2][2];
    const char* cA = cur.A; const char* cB = cur.B;
    G_STAGE(G_SB(0, 0), cB, voffB); G_STAGE(G_SB(0, 1), cB + hstep, voffB); G_STAGE(G_SA(0, 0), cA, voffA); G_STAGE(G_SA(0, 1), cA + hstep, voffA);
    if (wr == 1) G_BAR;
    G_WAIT_V(2); G_BAR;
    G_STAGE(G_SB(1, 0), cB + kstep, voffB); G_STAGE(G_SA(1, 0), cA + kstep, voffA); G_STAGE(G_SB(1, 1), cB + hstep + kstep, voffB);
    G_WAIT_V(6); G_BAR;
    for (;;) {
        const bool has_next = S.next(ui + 1, nxt);
        const char* nA = has_next ? nxt.A : cA; const char* nB = has_next ? nxt.B : cB;
        for (int t = 0; t < nt; t += 2) {
            const bool last = (t == nt - 2);
            const char* a1 = cA + (size_t)(t + 1) * kstep;
            const char* a2 = last ? nA : cA + (size_t)(t + 2) * kstep; const char* b2 = last ? nB : cB + (size_t)(t + 2) * kstep;
            const char* a3 = a2 + kstep; const char* b3 = b2 + kstep;
            G_LDB(B0, 0, 0); G_LDB(B1, 0, 1); G_SCHED; G_LDA(At, 0, 0); G_STAGE(G_SA(1, 1), a1 + hstep, voffA);
            G_WAIT_V(8); G_WAIT_L(0); G_BAR; G_MMA(0, 0, At, B0); G_MMA(0, 1, At, B1); G_BAR; G_SCHED;
            G_LDA(At, 0, 1); G_STAGE(G_SB(0, 0), b2, voffB); G_STAGE(G_SB(0, 1), b2 + hstep, voffB); G_STAGE(G_SA(0, 0), a2, voffA);
            G_WAIT_V(8); G_WAIT_L(0); G_BAR; G_MMA(1, 0, At, B0); G_MMA(1, 1, At, B1); G_BAR; G_SCHED;
            G_LDB(B0, 1, 0); G_LDB(B1, 1, 1); G_SCHED; G_LDA(At, 1, 0); G_STAGE(G_SA(0, 1), a2 + hstep, voffA);
            G_WAIT_V(8); G_WAIT_L(0); G_BAR; G_MMA(0, 0, At, B0); G_MMA(0, 1, At, B1); G_BAR; G_SCHED;
            G_LDA(At, 1, 1); G_STAGE(G_SB(1, 0), b3, voffB); G_STAGE(G_SB(1, 1), b3 + hstep, voffB); G_STAGE(G_SA(1, 0), a3, voffA);
            G_WAIT_V(8); G_WAIT_L(0); G_BAR; G_MMA(1, 0, At, B0); G_MMA(1, 1, At, B1); G_BAR; G_SCHED;
        }
        if (wr == 0) G_BAR;
        const bool keep = E(acc, cur, wr, wc, fr, fq);
        if (!has_next) break;
        if (!keep) G_ZERO();
        cur = nxt; cA = nA; cB = nB; ++ui;
        if (wr == 1) G_BAR;
    }
    G_WAIT_V(0);
    G_BAR;
#undef G_SA
#undef G_SB
#undef G_STAGE
#undef G_LDA
#undef G_LDB
#undef G_MMA
#undef G_ZERO
}

constexpr size_t TSTEP1024 = (size_t)256 * DM * 2, TSTEP_FF = (size_t)256 * DFF * 2;
struct SchedInProj {
    const char* U; const char* UC; const char* W; int G, c;
    DI bool next(int i, Unit& u) const {
        const int L = i * G + c;
        if (L < 128 * 24) { static_order(L, 128, 24, u.pm, u.pn); u.kind = 0; u.A = U + (size_t)u.pm * TSTEP1024; u.B = W + (size_t)u.pn * TSTEP1024; return true; }
        if (L < 128 * 24 + 64) { const int j = L - 128 * 24; u.pm = j >> 3; u.pn = j & 3; u.kind = 1 + ((j >> 2) & 1); u.A = UC + (size_t)u.pm * TSTEP1024; u.B = W + (size_t)((u.kind == 2 ? 8 : 0) + u.pn) * TSTEP1024; return true; }
        return false;
    }
};
struct SchedPlain {
    const char* A; const char* B; int nM, nN, G, c; size_t tstep;
    DI bool next(int i, Unit& u) const {
        const int L = i * G + c; if (L >= nM * nN) return false;
        static_order(L, nM, nN, u.pm, u.pn); u.kind = 0; u.A = A + (size_t)u.pm * tstep; u.B = B + (size_t)u.pn * tstep; return true;
    }
};
struct SchedBranch {
    const char* A0; const char* B0; const char* A1; const char* B1; int G, c;
    DI bool next(int i, Unit& u) const {
        const int L = (i >> 1) * G + c; if (L >= 128 * 4) return false;
        static_order(L, 128, 4, u.pm, u.pn); u.kind = i & 1;
        u.A = (u.kind ? A1 : A0) + (size_t)u.pm * TSTEP1024; u.B = (u.kind ? B1 : B0) + (size_t)u.pn * TSTEP1024; return true;
    }
};
#define EPI_LOOP(...) _Pragma("unroll") for (int ai = 0; ai < 2; ++ai) _Pragma("unroll") for (int m = 0; m < 4; ++m) { const int row = u.pm * 256 + ai * 128 + wr * 64 + m * 16 + fr; \
    _Pragma("unroll") for (int bj = 0; bj < 2; ++bj) _Pragma("unroll") for (int n = 0; n < 2; ++n) { const int ct = bj * 128 + wc * 32 + n * 16 + fq * 4; f32x4& v = acc[ai][bj][m][n]; __VA_ARGS__ } }
#define EPI_LOOP8(...) _Pragma("unroll") for (int ai = 0; ai < 2; ++ai) _Pragma("unroll") for (int m = 0; m < 4; ++m) { const int row = u.pm * 256 + ai * 128 + wr * 64 + m * 16 + fr; \
    _Pragma("unroll") for (int bj = 0; bj < 2; ++bj) { const int ct = bj * 128 + wc * 32 + fq * 8; f32x4& v0 = acc[ai][bj][m][0]; f32x4& v1 = acc[ai][bj][m][1]; __VA_ARGS__ } }
DI uint4 pack8(const f32x4& a, const f32x4& b) { uint4 w; w.x = cvt_pk_bf16(a[0], a[1]); w.y = cvt_pk_bf16(a[2], a[3]); w.z = cvt_pk_bf16(b[0], b[1]); w.w = cvt_pk_bf16(b[2], b[3]); return w; }
DI void unpack8(const uint4 w, float (&f)[8]) {
    f[0] = __uint_as_float(w.x << 16); f[1] = __uint_as_float(w.x & 0xffff0000u); f[2] = __uint_as_float(w.y << 16); f[3] = __uint_as_float(w.y & 0xffff0000u);
    f[4] = __uint_as_float(w.z << 16); f[5] = __uint_as_float(w.z & 0xffff0000u); f[6] = __uint_as_float(w.w << 16); f[7] = __uint_as_float(w.w & 0xffff0000u);
}
struct EpiInProj {
    static constexpr bool PERM = true;
    bf16_t* base; bf16_t* rgxc; bf16_t* mlxc;
    DI bool operator()(Acc& acc, const Unit& u, int wr, int wc, int fr, int fq) const {
        if (u.kind == 0) {
            const int t = u.pn >> 2; bf16_t* dst = base + (size_t)t * MROWS * DM + (u.pn & 3) * 256;
            EPI_LOOP8(
                if (t == 1) {
                    _Pragma("unroll") for (int j = 0; j < 4; ++j) { v0[j] = gelu_tanh(v0[j]); v1[j] = gelu_tanh(v1[j]); } }
                else if (t >= 3) {
                    _Pragma("unroll") for (int j = 0; j < 4; ++j) { v0[j] = sigmoidf_(v0[j]); v1[j] = sigmoidf_(v1[j]); } }
                const int orow = (t == 2) ? ((row & ~4095) | lat_tok(row & 4095)) : row;
                *(uint4*)(dst + (size_t)orow * DM + ct) = pack8(v0, v1); )
        } else {
            bf16_t* dst = (u.kind == 1 ? rgxc : mlxc) + u.pn * 256;
            EPI_LOOP8( *(uint4*)(dst + (size_t)row * DM + ct) = pack8(v0, v1); )
        }
        return false;
    }
};
struct EpiBranch {
    static constexpr bool PERM = true;
    const bf16_t* sgr; const bf16_t* sgm; bf16_t* mix;
    DI bool operator()(Acc& acc, const Unit& u, int wr, int wc, int fr, int fq) const {
        if (u.kind == 0) {
            EPI_LOOP8( const size_t o = (size_t)row * DM + u.pn * 256 + ct; float a[8], b[8]; unpack8(*(const uint4*)(sgr + o), a); unpack8(*(const uint4*)(sgm + o), b);
                _Pragma("unroll") for (int j = 0; j < 4; ++j) { v0[j] *= a[j] * frcp(b[j]); v1[j] *= a[4 + j] * frcp(b[4 + j]); }
                asm volatile("" ::: "memory"); )
            return true;
        }
        EPI_LOOP8( const size_t o = (size_t)row * DM + u.pn * 256 + ct; float b[8]; unpack8(*(const uint4*)(sgm + o), b);
            f32x4 r0, r1;
            _Pragma("unroll") for (int j = 0; j < 4; ++j) { r0[j] = v0[j] * b[j]; r1[j] = v1[j] * b[4 + j]; }
            *(uint4*)(mix + o) = pack8(r0, r1); asm volatile("" ::: "memory"); )
        return false;
    }
};
struct EpiOutProj {
    static constexpr bool PERM = false;
    const float* x; const float* modl; float* x1;
    DI bool operator()(Acc& acc, const Unit& u, int wr, int wc, int fr, int fq) const {
        const float* g1 = modl + (u.pm >> 4) * NIN + 2048 + u.pn * 256;
        EPI_LOOP( const size_t o = (size_t)row * DM + u.pn * 256 + ct; const float4 g = *(const float4*)(g1 + ct), xx = *(const float4*)(x + o);
            float4 r; r.x = xx.x + g.x * v[0]; r.y = xx.y + g.y * v[1]; r.z = xx.z + g.z * v[2]; r.w = xx.w + g.w * v[3]; *(float4*)(x1 + o) = r; )
        return false;
    }
};
struct EpiFfnIn {
    static constexpr bool PERM = true;
    bf16_t* act;
    DI bool operator()(Acc& acc, const Unit& u, int wr, int wc, int fr, int fq) const {
#pragma unroll
        for (int ai = 0; ai < 2; ++ai)
#pragma unroll
            for (int m = 0; m < 4; ++m) { const int row = u.pm * 256 + ai * 128 + wr * 64 + m * 16 + fr;
                f32x4 r0, r1;
#pragma unroll
                for (int j = 0; j < 4; ++j) { r0[j] = siluf_(acc[ai][0][m][0][j]) * acc[ai][1][m][0][j]; r1[j] = siluf_(acc[ai][0][m][1][j]) * acc[ai][1][m][1][j]; }
                *(uint4*)(act + (size_t)row * DFF + u.pn * 128 + wc * 32 + fq * 8) = pack8(r0, r1); }
        return false;
    }
};
struct EpiFfnOut {
    static constexpr bool PERM = false;
    float* x12; const float* modl;
    DI bool operator()(Acc& acc, const Unit& u, int wr, int wc, int fr, int fq) const {
        const float* g2 = modl + (u.pm >> 4) * NIN + 5120 + u.pn * 256;
        EPI_LOOP( const size_t o = (size_t)row * DM + u.pn * 256 + ct; const float4 g = *(const float4*)(g2 + ct); float4 xx = *(const float4*)(x12 + o);
            xx.x += g.x * v[0]; xx.y += g.y * v[1]; xx.z += g.z * v[2]; xx.w += g.w * v[3]; *(float4*)(x12 + o) = xx; )
        return false;
    }
};

#endif
__device__ __forceinline__ void phase_rg_naive(const Params& P) {
    const int tid = threadIdx.x, wid = tid >> 6, lane = tid & 63;
    const bf16_t* rgx = (const bf16_t*)(P.ws + OFF_RGX); const bf16_t* rgxc = (const bf16_t*)(P.ws + OFF_RGXC); const bf16_t* ggelu = (const bf16_t*)(P.ws + OFF_GGELU);
    bf16_t* yrg = (bf16_t*)(P.ws + OFF_U); float* HB = P.out;
    for (int item = wid * gridDim.x + blockIdx.x; item < NB * 16; item += gridDim.x * 8) {
        const int b = item >> 4, n = item & 15, ch = n * 64 + lane;
        float cw[4];
#pragma unroll
        for (int j = 0; j < 4; ++j) cw[j] = P.rg_conv_w[j * DM + ch];
        const float cb = P.rg_conv_b[ch];
        for (int pass = 0; pass < 2; ++pass) {
            const int d = 1 - pass;
            float wa_r[64], wx_r[64];
#pragma unroll
            for (int i = 0; i < 64; ++i) { wa_r[i] = P.rg_wa[((size_t)(d * 16 + n) * 64 + i) * 64 + lane]; wx_r[i] = P.rg_wx[((size_t)(d * 16 + n) * 64 + i) * 64 + lane]; }
            const float ba = P.rg_ba[d * DM + ch], bx = P.rg_bx[d * DM + ch];
            const float cA = -8.0f * softplusf_(-P.rg_lambda[d * DM + ch]);
            float h = 0.f;
            for (int sq = 0; sq < 2; ++sq) {
                const int Ls = sq ? SEQ : CTXL;
                const bf16_t* X = sq ? rgx + (size_t)b * SEQ * DM : rgxc + (size_t)b * CTXL * DM;
                for (int s = 0; s < Ls; ++s) {
                    const int t = d ? Ls - 1 - s : s;
                    float xc = cb;
#pragma unroll
                    for (int j = 0; j < 4; ++j) { const int tt = t + j - 2; if (tt >= 0 && tt < Ls) xc += cw[j] * bf2f(X[(size_t)tt * DM + ch]); }
                    float ra = ba, ri = bx;
#pragma unroll
                    for (int i = 0; i < 64; ++i) { const float xi = __int_as_float(__builtin_amdgcn_readlane(__float_as_int(xc), i)); ra += xi * wa_r[i]; ri += xi * wx_r[i]; }
                    const float r = sigmoidf_(ra), ig = sigmoidf_(ri);
                    const float log_a = cA * r, a = expf(log_a), bb = sqrtf(-expm1f(2.0f * log_a)) * (ig * xc);
                    h = a * h + bb;
                    if (sq) {
                        const size_t o = ((size_t)b * SEQ + t) * DM + ch;
                        if (d) HB[o] = h; else yrg[o] = f2bf((h + HB[o]) * bf2f(ggelu[o]));
                    }
                }
            }
        }
    }
}

constexpr int RG_WTOT = 0, RG_XCS = 4096, RG_CWT = RG_XCS + 8 * 16 * 33 * 4, RG_LDS = RG_CWT + 64 * 8 * 4;
DI float neg_expm1(float x) {
    return x > -0.1f ? -x * (1.0f + x * (0.5f + x * (0.16666667f + x * 0.041666668f))) : 1.0f - __expf(x);
}
template <int d>
__device__ __forceinline__ void rg_pass(const Params& P, char* smem, const int b, const int n, const int half) {
    const int tid = threadIdx.x, wid = tid >> 6, lane0 = tid & 63;
    const bf16_t* rgx = (const bf16_t*)(P.ws + OFF_RGX) + (size_t)b * SEQ * DM; const bf16_t* rgxc = (const bf16_t*)(P.ws + OFF_RGXC) + (size_t)b * CTXL * DM;
    const bf16_t* ggelu = (const bf16_t*)(P.ws + OFF_GGELU) + (size_t)b * SEQ * DM; bf16_t* yrg = (bf16_t*)(P.ws + OFF_U) + (size_t)b * SEQ * DM; bf16_t* HB = (bf16_t*)P.out + (size_t)b * SEQ * DM;
    bf16x8 wfa[2][2], wfx[2][2];
    float ba[2], bx[2], cA[2];
    {
        const int fr = lane0 & 15, fq = lane0 >> 4;
#pragma unroll
        for (int ks = 0; ks < 2; ++ks)
#pragma unroll
            for (int nt = 0; nt < 2; ++nt)
#pragma unroll
                for (int j = 0; j < 8; ++j) { const size_t wi_ = ((size_t)(d * 16 + n) * 64 + 32 * ks + 8 * fq + j) * 64 + 32 * half + 16 * nt + fr;
                    wfa[ks][nt][j] = (short)f2bf(P.rg_wa[wi_]); wfx[ks][nt][j] = (short)f2bf(P.rg_wx[wi_]); }
#pragma unroll
        for (int nt = 0; nt < 2; ++nt) { const int ch = 64 * n + 32 * half + 16 * nt + fr; ba[nt] = P.rg_ba[d * DM + ch]; bx[nt] = P.rg_bx[d * DM + ch]; cA[nt] = -8.0f * softplusf_(-P.rg_lambda[d * DM + ch]); }
    }
    float hc[2] = {0.f, 0.f};
    uint4 raw[4][2];
    auto tile_geo = [&](int ti_, int& sq, int& T0, int& Ls) { sq = ti_ >= 2; const int k = sq ? ti_ - 2 : ti_, nts = sq ? 32 : 2; T0 = 128 * (d ? nts - 1 - k : k); Ls = sq ? SEQ : CTXL; };
    auto load_raw = [&](int ti_, const int lane) {
        int sq, T0, Ls; tile_geo(ti_, sq, T0, Ls);
        const int fr = lane & 15, fq = lane >> 4, tauA = 16 * wid + fr, tA = d ? T0 + 127 - tauA : T0 + tauA;
        const bf16_t* X = sq ? rgx : rgxc;
#pragma unroll
        for (int j = 0; j < 4; ++j) { const int tt = tA + j - 2; const bool ok = tt >= 0 && tt < Ls; const int tc = ok ? tt : tA;
#pragma unroll
            for (int ks = 0; ks < 2; ++ks) { uint4 v = *(const uint4*)(X + (size_t)tc * DM + 64 * n + 32 * ks + 8 * fq); if (!ok) { v.x = v.y = v.z = v.w = 0u; } raw[j][ks] = v; } }
    };
    load_raw(0, lane0);
    for (int ti_ = 0; ti_ < 34; ++ti_) {
        int lane = lane0; LAUNDER(lane);
        const int fr = lane & 15, fq = lane >> 4;
        int sq, T0, Ls; tile_geo(ti_, sq, T0, Ls);
        bf16_t hbv[2][4]; bf16_t ggv[2][4];
        if (sq && d == 0) {
#pragma unroll
            for (int nt = 0; nt < 2; ++nt)
#pragma unroll
                for (int j = 0; j < 4; ++j) { const int tau = 16 * wid + 4 * fq + j, t = T0 + tau; const size_t o = (size_t)t * DM + 64 * n + 32 * half + 16 * nt + fr; hbv[nt][j] = HB[o]; ggv[nt][j] = ggelu[o]; }
        }
        bf16x8 af[2];
        {
            const float* cwt = (const float*)(smem + RG_CWT);
            float* xcs = (float*)(smem + RG_XCS) + wid * 16 * 33;
#pragma unroll
            for (int ks = 0; ks < 2; ++ks) {
                float u[4][8];
#pragma unroll
                for (int j = 0; j < 4; ++j) { uint2 lo, hi; lo.x = raw[j][ks].x; lo.y = raw[j][ks].y; hi.x = raw[j][ks].z; hi.y = raw[j][ks].w; float a4[4], b4[4]; unpack4(lo, a4); unpack4(hi, b4);
#pragma unroll
                    for (int c = 0; c < 4; ++c) { u[j][c] = a4[c]; u[j][4 + c] = b4[c]; } }
                float xa[8];
#pragma unroll
                for (int c = 0; c < 8; ++c) { const float4 w = *(const float4*)(cwt + (32 * ks + 8 * fq + c) * 8); const float bb = cwt[(32 * ks + 8 * fq + c) * 8 + 4];
                    xa[c] = bb + w.x * u[0][c] + w.y * u[1][c] + w.z * u[2][c] + w.w * u[3][c]; }
                const uint2 p0 = pack4(xa[0], xa[1], xa[2], xa[3]), p1 = pack4(xa[4], xa[5], xa[6], xa[7]);
                uint4 pk; pk.x = p0.x; pk.y = p0.y; pk.z = p1.x; pk.w = p1.y; af[ks] = __builtin_bit_cast(bf16x8, pk);
                if (ks == half) {
#pragma unroll
                    for (int c = 0; c < 8; ++c) xcs[fr * 33 + 8 * fq + c] = xa[c];
                }
            }
        }
        if (ti_ + 1 < 34) load_raw(ti_ + 1, lane);
        f32x4 Da[2], Dx[2];
#pragma unroll
        for (int nt = 0; nt < 2; ++nt) {
            Da[nt] = __builtin_amdgcn_mfma_f32_16x16x32_bf16(af[0], wfa[0][nt], (f32x4){0.f, 0.f, 0.f, 0.f}, 0, 0, 0);
            Da[nt] = __builtin_amdgcn_mfma_f32_16x16x32_bf16(af[1], wfa[1][nt], Da[nt], 0, 0, 0);
            Dx[nt] = __builtin_amdgcn_mfma_f32_16x16x32_bf16(af[0], wfx[0][nt], (f32x4){0.f, 0.f, 0.f, 0.f}, 0, 0, 0);
            Dx[nt] = __builtin_amdgcn_mfma_f32_16x16x32_bf16(af[1], wfx[1][nt], Dx[nt], 0, 0, 0);
        }
        float av[2][4], bv[2][4], Aq[2], Bq[2];
        {
            const float* xcs = (const float*)(smem + RG_XCS) + wid * 16 * 33;
#pragma unroll
            for (int nt = 0; nt < 2; ++nt) {
                float A = 1.f, B = 0.f;
#pragma unroll
                for (int j = 0; j < 4; ++j) {
                    const float xc = xcs[(4 * fq + j) * 33 + 16 * nt + fr];
                    const float r = sigmoidf_(Da[nt][j] + ba[nt]), ig = sigmoidf_(Dx[nt][j] + bx[nt]);
                    const float log_a = cA[nt] * r, a = __expf(log_a), bb = sqrtf(neg_expm1(2.0f * log_a)) * (ig * xc);
                    av[nt][j] = a; bv[nt][j] = bb; B = a * B + bb; A *= a;
                }
                float Ap = __shfl_up(A, 16), Bp = __shfl_up(B, 16);
                if (fq >= 1) { B = A * Bp + B; A = A * Ap; }
                Ap = __shfl_up(A, 32); Bp = __shfl_up(B, 32);
                if (fq >= 2) { B = A * Bp + B; A = A * Ap; }
                Aq[nt] = A; Bq[nt] = B;
            }
        }
        float* wtot = (float*)(smem + RG_WTOT) + (ti_ & 1) * 512;
        if (fq == 3) {
#pragma unroll
            for (int nt = 0; nt < 2; ++nt) { wtot[(wid * 32 + 16 * nt + fr) * 2] = Aq[nt]; wtot[(wid * 32 + 16 * nt + fr) * 2 + 1] = Bq[nt]; }
        }
        __syncthreads();
#pragma unroll
        for (int nt = 0; nt < 2; ++nt) {
            float Ae = __shfl_up(Aq[nt], 16), Be = __shfl_up(Bq[nt], 16);
            if (fq == 0) { Ae = 1.f; Be = 0.f; }
            float h = hc[nt], hw = hc[nt];
#pragma unroll
            for (int w = 0; w < 8; ++w) { const float Aw = wtot[(w * 32 + 16 * nt + fr) * 2], Bw = wtot[(w * 32 + 16 * nt + fr) * 2 + 1]; h = Aw * h + Bw; if (w < wid) hw = h; }
            hc[nt] = h;
            float hh = Ae * hw + Be;
#pragma unroll
            for (int j = 0; j < 4; ++j) {
                hh = av[nt][j] * hh + bv[nt][j];
                if (sq) {
                    const int tau = 16 * wid + 4 * fq + j, t = d ? T0 + 127 - tau : T0 + tau; const size_t o = (size_t)t * DM + 64 * n + 32 * half + 16 * nt + fr;
                    if (d) HB[o] = f2bf(hh); else yrg[o] = f2bf((hh + bf2f(hbv[nt][j])) * bf2f(ggv[nt][j]));
                }
            }
        }
    }
}
__device__ __forceinline__ void phase_rg(const Params& P, char* smem) {
    for (int item = blockIdx.x; item < 256; item += gridDim.x) {
        const int half = item & 1, n = (item >> 1) & 15, b = item >> 5;
        __syncthreads();
        float* cwt = (float*)(smem + RG_CWT);
        for (int i = threadIdx.x; i < 64 * 8; i += 512) { const int ch = i >> 3, e = i & 7; cwt[i] = e < 4 ? P.rg_conv_w[e * DM + 64 * n + ch] : (e == 4 ? P.rg_conv_b[64 * n + ch] : 0.f); }
        __syncthreads();
        rg_pass<1>(P, smem, b, n, half);
        __syncthreads();
        rg_pass<0>(P, smem, b, n, half);
    }
}

DI const bf16_t* ml_row(const Params& P, int b, int sq, int pos) {
    return sq ? (const bf16_t*)(P.ws + OFF_MLX) + ((size_t)b * SEQ + pos) * DM : (const bf16_t*)(P.ws + OFF_MLXC) + ((size_t)b * CTXL + pos) * DM;
}
DI bf16_t* xm_row(const Params& P, int b, int sq, int pos) {
    return sq ? (bf16_t*)P.out + (size_t)MROWS * DM + ((size_t)b * SEQ + pos) * DM : (bf16_t*)(P.ws + OFF_UC) + ((size_t)b * CTXL + pos) * DM;
}

__device__ __forceinline__ void phase_mlstm_naive(const Params& P, char* smem) {
    float* xm_s = (float*)smem; float* u_s = xm_s + 256; float* q_s = u_s + 256; float* k_s = q_s + 256; float* v_s = k_s + 256;
    const int tid = threadIdx.x, vloc = tid >> 4, kseg = tid & 15;
    const float* logi = (const float*)(P.ws + OFF_LOGI); const float* logf_ = (const float*)(P.ws + OFF_LOGF);
    for (int item = blockIdx.x; item < NB * 4 * 2 * 8; item += gridDim.x) {
        const int vs = item & 7, d = (item >> 3) & 1, hd = (item >> 4) & 3, b = item >> 6;
        bf16_t* Hd = (bf16_t*)(P.ws + (d ? OFF_GGELU : OFF_RGX));
        float C[16], nn[16];
#pragma unroll
        for (int i = 0; i < 16; ++i) { C[i] = 0.f; nn[i] = 0.f; }
        float m = 0.f;
        float cw[4] = {0.f, 0.f, 0.f, 0.f}, cb = 0.f, wq_r[4] = {0.f, 0.f, 0.f, 0.f}, wk_r[4] = {0.f, 0.f, 0.f, 0.f};
        int cg = 0;
        if (tid < 256) { cg = 256 * hd + tid;
#pragma unroll
            for (int j = 0; j < 4; ++j) cw[j] = P.ml_conv_w[j * DM + cg];
            cb = P.ml_conv_b[cg];
#pragma unroll
            for (int i = 0; i < 4; ++i) { wq_r[i] = P.ml_wq[((cg >> 2) * 4 + i) * 4 + (cg & 3)]; wk_r[i] = P.ml_wk[((cg >> 2) * 4 + i) * 4 + (cg & 3)]; }
        } else if (tid < 288) { cg = 256 * hd + 32 * vs + (tid - 256);
#pragma unroll
            for (int i = 0; i < 4; ++i) wq_r[i] = P.ml_wv[((cg >> 2) * 4 + i) * 4 + (cg & 3)];
        }
        for (int sq = 0; sq < 2; ++sq) {
            const int Ls = sq ? SEQ : CTXL, lo = sq ? CTXL : 0;
            for (int s = 0; s < Ls; ++s) {
                const int pos = d ? Ls - 1 - s : s;
                if (tid < 256) {
                    float a = cb, ucur = 0.f;
#pragma unroll
                    for (int j = 0; j < 4; ++j) { const int pp = pos + j - 2; if (pp >= 0 && pp < Ls) { const float uv = bf2f(ml_row(P, b, sq, pp)[cg]); a += cw[j] * uv; if (j == 2) ucur = uv; } }
                    xm_s[tid] = siluf_(a); u_s[tid] = ucur;
                }
                __syncthreads();
                if (tid < 256) { const int g4 = tid & ~3; float q = 0.f, k = 0.f;
#pragma unroll
                    for (int i = 0; i < 4; ++i) { q += xm_s[g4 + i] * wq_r[i]; k += xm_s[g4 + i] * wk_r[i]; }
                    q_s[tid] = q; k_s[tid] = k * 0.0625f;
                } else if (tid < 288) { const int j = tid - 256, g4 = (32 * vs + j) & ~3; float v = 0.f;
#pragma unroll
                    for (int i = 0; i < 4; ++i) v += u_s[g4 + i] * wq_r[i];
                    v_s[j] = v; }
                __syncthreads();
                const size_t gi = ((size_t)(b * 2 + d) * 4 + hd) * LTOT + lo + pos;
                const float li = logi[gi], lf = logf_[gi];
                const float m_new = fmaxf(lf + m, li), fd = expf(lf + m - m_new), iw = expf(li - m_new);
                const float vv = v_s[vloc] * iw; float num = 0.f, den = 0.f;
#pragma unroll
                for (int kk = 0; kk < 16; ++kk) { const float kq = k_s[kseg * 16 + kk], qq = q_s[kseg * 16 + kk];
                    C[kk] = fd * C[kk] + vv * kq; nn[kk] = fd * nn[kk] + iw * kq; num += C[kk] * qq; den += nn[kk] * qq; }
#pragma unroll
                for (int o = 8; o > 0; o >>= 1) { num += __shfl_xor(num, o); den += __shfl_xor(den, o); }
                if (sq && kseg == 0) Hd[((size_t)b * SEQ + pos) * DM + 256 * hd + 32 * vs + vloc] = f2bf(num / fmaxf(fabsf(den), expf(-m_new)));
                m = m_new;
            }
        }
        __syncthreads();
    }
}

constexpr int ML_QS = 0, ML_KS = ML_QS + 64 * 528, ML_CS = ML_KS + 64 * 528, ML_VT = ML_CS + 80 * 528, ML_VW = ML_VT + 80 * 144, ML_SS = ML_VW + 80 * 144, ML_SC = ML_SS + 64 * 144,
              ML_SCB = 1536, ML_WT = ML_SC + 2 * ML_SCB, ML_US = ML_WT + 1024, ML_LDS = ML_US + 64 * 128;
constexpr int ML_XM = ML_QS;
typedef short s16x4 __attribute__((ext_vector_type(4)));
DI float wave_incl_sum(float v, int lane) {
#pragma unroll
    for (int o = 1; o < 64; o <<= 1) { const float t = __shfl_up(v, o); if (lane >= o) v += t; }
    return v;
}
DI float wave_incl_max(float v, int lane) {
#pragma unroll
    for (int o = 1; o < 64; o <<= 1) { const float t = __shfl_up(v, o); if (lane >= o) v = fmaxf(v, t); }
    return v;
}
struct MlChunk { int sq, P0, Ls, lo; };
DI MlChunk ml_chunk(int cidx, int d) { MlChunk c; c.sq = cidx >= 4; const int blk = c.sq ? cidx - 4 : cidx, nblk = c.sq ? 64 : 4; c.P0 = 64 * (d ? nblk - 1 - blk : blk); c.Ls = c.sq ? SEQ : CTXL; c.lo = c.sq ? CTXL : 0; return c; }

template <int d>
__device__ __forceinline__ void mlstm_item(const Params& P, char* smem, const int vq, const int hd, const int b) {
    const int tid = threadIdx.x, wid = tid >> 6, lane0 = tid & 63;
    bf16_t* Qs = (bf16_t*)(smem + ML_QS); bf16_t* Ks = (bf16_t*)(smem + ML_KS); bf16_t* Cs = (bf16_t*)(smem + ML_CS);
    bf16_t* VT = (bf16_t*)(smem + ML_VT); bf16_t* VW = (bf16_t*)(smem + ML_VW); bf16_t* Ss = (bf16_t*)(smem + ML_SS);
    const float* logi = (const float*)(P.ws + OFF_LOGI); const float* logf_ = (const float*)(P.ws + OFF_LOGF);
    const int ti = wid >> 1, pr = wid & 1;
    bf16_t* Hd = (bf16_t*)(P.ws + (d ? OFF_GGELU : OFF_RGX));
    const size_t chain = ((size_t)(b * 2 + d) * 4 + hd) * LTOT;
    __syncthreads();
    float* wt = (float*)(smem + ML_WT);
    if (tid < 256) wt[tid] = P.ml_wv[(((256 * hd) >> 2) + 16 * vq + (tid >> 4)) * 16 + (tid & 15)];
    bf16x8 Aq[2], Ak[2], Aql[2], Akl[2];
    {
        const int fr_ = lane0 & 15, fq_ = lane0 >> 4;
#pragma unroll
        for (int h = 0; h < 2; ++h)
#pragma unroll
            for (int j = 0; j < 8; ++j) { const int ing = 2 * fq_ + (j >> 2), outg = 4 * h + (fr_ >> 2); const int wi_ = ((((256 * hd + 32 * wid) >> 2) + outg) * 4 + (j & 3)) * 4 + (fr_ & 3);
                const bool on = ing == outg; const float wq_ = on ? P.ml_wq[wi_] : 0.f, wk_ = on ? P.ml_wk[wi_] * 0.0625f : 0.f;
                const bf16_t qh_ = f2bf(wq_), kh_ = f2bf(wk_);
                Aq[h][j] = (short)qh_; Ak[h][j] = (short)kh_; Aql[h][j] = (short)f2bf(wq_ - bf2f(qh_)); Akl[h][j] = (short)f2bf(wk_ - bf2f(kh_)); }
    }
    f32x4 X[2][5];
#pragma unroll
    for (int x = 0; x < 2; ++x)
#pragma unroll
        for (int vi = 0; vi < 5; ++vi) X[x][vi] = (f32x4){0.f, 0.f, 0.f, 0.f};
    for (int i = tid; i < 80 * 264 / 2; i += 512) ((unsigned*)Cs)[i] = 0u;
    for (int i = tid; i < 16 * 72; i += 512) { VT[64 * 72 + i] = (i < 72) ? (bf16_t)0x3F80 : (bf16_t)0; VW[64 * 72 + i] = 0; }
    float m_run = 0.f;
    float li_n = 0.f, lf_n = 0.f;
    auto load_gates = [&](int cidx, const int lane) { const MlChunk c = ml_chunk(cidx, d); const size_t gi = chain + c.lo + c.P0 + (d ? 63 - lane : lane); li_n = logi[gi]; lf_n = logf_[gi]; };
    auto scalars = [&](int cidx, const int lane) {
        float* sc = (float*)(smem + ML_SC + (cidx & 1) * ML_SCB);
        const float li = li_n, lf = lf_n;
        if (cidx + 1 < 68) load_gates(cidx + 1, lane);
        const float bcum = wave_incl_sum(lf, lane), colv = li - bcum, pmax = wave_incl_max(colv, lane);
        const float M = fmaxf(m_run, pmax), M63 = __shfl(M, 63), bL = __shfl(bcum, 63);
        sc[lane] = M; sc[64 + lane] = colv; sc[128 + lane] = __expf(m_run - M); sc[192 + lane] = __expf(-(bcum + M)); sc[256 + lane] = __expf(colv - M63);
        if (lane == 0) sc[320] = __expf(m_run - M63);
        m_run = bL + M63;
    };
    auto dma_raw = [&](int cidx, const int lane) {
        const MlChunk c = ml_chunk(cidx, d);
#pragma unroll
        for (int it = 0; it < 4; ++it) {
            const int k = wid + 8 * it, row = 2 * k + (lane >> 5), cp = lane & 31;
            const char* gp = (const char*)(xm_row(P, b, c.sq, c.P0 + row) + 256 * hd) + ((cp ^ (row & 15)) * 16);
#ifndef EMU
            __builtin_amdgcn_global_load_lds((const unsigned*)gp, (LAS unsigned*)(smem + ML_XM + k * 1024), 16, 0, 0);
#else
            memcpy(smem + ML_XM + k * 1024 + lane * 16, gp, 16);
#endif
        }
        {
            const int row = 8 * wid + (lane >> 3);
            const char* gp = (const char*)(ml_row(P, b, c.sq, c.P0 + row) + 256 * hd + 64 * vq) + (lane & 7) * 16;
#ifndef EMU
            __builtin_amdgcn_global_load_lds((const unsigned*)gp, (LAS unsigned*)(smem + ML_US + wid * 1024), 16, 0, 0);
#else
            memcpy(smem + ML_US + wid * 1024 + lane * 16, gp, 16);
#endif
        }
    };
    uint2 qh[4][2];
    auto fill_a = [&](int cidx, const int lane) {
        const float* sc = (const float*)(smem + ML_SC + (cidx & 1) * ML_SCB);
        const int fr = lane & 15, fq = lane >> 4;
#pragma unroll
        for (int st = 0; st < 4; ++st) {
            const int r = 16 * st + fr, s = d ? 63 - r : r;
            const bf16x8 bx = *(const bf16x8*)(smem + ML_XM + r * 512 + (((4 * wid + fq) ^ fr) * 16));
#pragma unroll
            for (int h = 0; h < 2; ++h) {
                f32x4 qd = __builtin_amdgcn_mfma_f32_16x16x32_bf16(Aql[h], bx, (f32x4){0.f, 0.f, 0.f, 0.f}, 0, 0, 0); qd = __builtin_amdgcn_mfma_f32_16x16x32_bf16(Aq[h], bx, qd, 0, 0, 0);
                f32x4 kd = __builtin_amdgcn_mfma_f32_16x16x32_bf16(Akl[h], bx, (f32x4){0.f, 0.f, 0.f, 0.f}, 0, 0, 0); kd = __builtin_amdgcn_mfma_f32_16x16x32_bf16(Ak[h], bx, kd, 0, 0, 0);
                qh[st][h] = pack4(qd[0], qd[1], qd[2], qd[3]);
                *(uint2*)(Ks + s * 264 + 32 * wid + 16 * h + 4 * fq) = pack4(kd[0], kd[1], kd[2], kd[3]);
            }
        }
        {
            const int gv = tid & 15, r0 = 2 * (tid >> 4), s_lo = d ? 62 - r0 : r0;
            const float4* wvp = (const float4*)((const float*)(smem + ML_WT) + gv * 16);
            const float4 w0 = wvp[0], w1 = wvp[1], w2 = wvp[2], w3 = wvp[3];
            float ua[4], ub[4]; unpack4(*(const uint2*)(smem + ML_US + r0 * 128 + 8 * gv), ua); unpack4(*(const uint2*)(smem + ML_US + (r0 + 1) * 128 + 8 * gv), ub);
            const float va[4] = {ua[0] * w0.x + ua[1] * w1.x + ua[2] * w2.x + ua[3] * w3.x, ua[0] * w0.y + ua[1] * w1.y + ua[2] * w2.y + ua[3] * w3.y, ua[0] * w0.z + ua[1] * w1.z + ua[2] * w2.z + ua[3] * w3.z, ua[0] * w0.w + ua[1] * w1.w + ua[2] * w2.w + ua[3] * w3.w};
            const float vb[4] = {ub[0] * w0.x + ub[1] * w1.x + ub[2] * w2.x + ub[3] * w3.x, ub[0] * w0.y + ub[1] * w1.y + ub[2] * w2.y + ub[3] * w3.y, ub[0] * w0.z + ub[1] * w1.z + ub[2] * w2.z + ub[3] * w3.z, ub[0] * w0.w + ub[1] * w1.w + ub[2] * w2.w + ub[3] * w3.w};
            const float wsl = sc[256 + s_lo], wsh = sc[256 + s_lo + 1];
#pragma unroll
            for (int o = 0; o < 4; ++o) { const float lo_ = d ? vb[o] : va[o], hi_ = d ? va[o] : vb[o];
                *(unsigned*)(VT + (4 * gv + o) * 72 + s_lo) = cvt_pk_bf16(lo_, hi_); *(unsigned*)(VW + (4 * gv + o) * 72 + s_lo) = cvt_pk_bf16(lo_ * wsl, hi_ * wsh); }
        }
        if (wid == 0) VW[64 * 72 + lane] = f2bf(sc[256 + lane]);
    };
    auto fill_b = [&](const int lane) {
        const int fr = lane & 15, fq = lane >> 4;
#pragma unroll
        for (int st = 0; st < 4; ++st) { const int r = 16 * st + fr, s = d ? 63 - r : r;
#pragma unroll
            for (int h = 0; h < 2; ++h) *(uint2*)(Qs + s * 264 + 32 * wid + 16 * h + 4 * fq) = qh[st][h]; }
    };
    if (wid == 0) { load_gates(0, lane0); scalars(0, lane0); }
    dma_raw(0, lane0);
#ifndef EMU
    asm volatile("s_waitcnt vmcnt(0)" ::: "memory");
#endif
    __syncthreads();
    for (int cidx = 0; cidx < 68; ++cidx) {
        int lane = lane0; LAUNDER(lane);
        const int fr = lane & 15, fq = lane >> 4;
        const MlChunk ck = ml_chunk(cidx, d);
        const float* sc = (const float*)(smem + ML_SC + (cidx & 1) * ML_SCB);
        fill_a(cidx, lane);
        __syncthreads();
        fill_b(lane);
        __syncthreads();
        f32x4 sacc[2], qacc[3];
        sacc[0] = sacc[1] = qacc[0] = qacc[1] = qacc[2] = (f32x4){0.f, 0.f, 0.f, 0.f};
        {
            const bf16_t* qrow = Qs + (16 * ti + fr) * 264 + 8 * fq;
            const bf16_t* k0 = Ks + (32 * pr + fr) * 264 + 8 * fq; const bf16_t* k1 = k0 + 16 * 264;
            const bf16_t* c0 = Cs + (32 * pr + fr) * 264 + 8 * fq; const bf16_t* c1 = c0 + 16 * 264; const bf16_t* c4 = Cs + (64 + fr) * 264 + 8 * fq;
#pragma unroll 4
            for (int ks = 0; ks < 8; ++ks) {
                const bf16x8 a = *(const bf16x8*)(qrow + 32 * ks);
                sacc[0] = __builtin_amdgcn_mfma_f32_16x16x32_bf16(a, *(const bf16x8*)(k0 + 32 * ks), sacc[0], 0, 0, 0);
                sacc[1] = __builtin_amdgcn_mfma_f32_16x16x32_bf16(a, *(const bf16x8*)(k1 + 32 * ks), sacc[1], 0, 0, 0);
                qacc[0] = __builtin_amdgcn_mfma_f32_16x16x32_bf16(a, *(const bf16x8*)(c0 + 32 * ks), qacc[0], 0, 0, 0);
                qacc[1] = __builtin_amdgcn_mfma_f32_16x16x32_bf16(a, *(const bf16x8*)(c1 + 32 * ks), qacc[1], 0, 0, 0);
                qacc[2] = __builtin_amdgcn_mfma_f32_16x16x32_bf16(a, *(const bf16x8*)(c4 + 32 * ks), qacc[2], 0, 0, 0);
            }
        }
#pragma unroll
        for (int s2 = 0; s2 < 2; ++s2) { const int s = 32 * pr + 16 * s2 + fr; const float cv = sc[64 + s];
#pragma unroll
            for (int j = 0; j < 4; ++j) { const int t = 16 * ti + 4 * fq + j; const float w = (s <= t) ? __expf(cv - sc[t]) : 0.f; Ss[t * 72 + s] = f2bf(sacc[s2][j] * w); } }
        __syncthreads();
        if (cidx + 1 < 68) dma_raw(cidx + 1, lane);
#pragma unroll
        for (int j = 0; j < 4; ++j) { const float si_ = sc[128 + 16 * ti + 4 * fq + j]; qacc[0][j] *= si_; qacc[1][j] *= si_; qacc[2][j] *= si_; }
        {
            const bf16_t* srow = Ss + (16 * ti + fr) * 72 + 8 * fq;
            const bf16_t* v0 = VT + (32 * pr + fr) * 72 + 8 * fq; const bf16_t* v1 = v0 + 16 * 72; const bf16_t* v4 = VT + (64 + fr) * 72 + 8 * fq;
#pragma unroll
            for (int k2 = 0; k2 < 2; ++k2) {
                const bf16x8 a = *(const bf16x8*)(srow + 32 * k2);
                qacc[0] = __builtin_amdgcn_mfma_f32_16x16x32_bf16(a, *(const bf16x8*)(v0 + 32 * k2), qacc[0], 0, 0, 0);
                qacc[1] = __builtin_amdgcn_mfma_f32_16x16x32_bf16(a, *(const bf16x8*)(v1 + 32 * k2), qacc[1], 0, 0, 0);
                qacc[2] = __builtin_amdgcn_mfma_f32_16x16x32_bf16(a, *(const bf16x8*)(v4 + 32 * k2), qacc[2], 0, 0, 0);
            }
        }
        float hv0[4], hv1[4];
#pragma unroll
        for (int j = 0; j < 4; ++j) {
            const float den = __shfl(qacc[2][j], lane & 48);
            const float rdn = frcp(fmaxf(fabsf(den), sc[192 + 16 * ti + 4 * fq + j]));
            hv0[j] = qacc[0][j] * rdn; hv1[j] = qacc[1][j] * rdn;
        }
        {
            const float dec = sc[320];
#pragma unroll
            for (int x = 0; x < 2; ++x)
#pragma unroll
                for (int vi = 0; vi < 5; ++vi) X[x][vi] *= dec;
#pragma unroll
            for (int k2 = 0; k2 < 2; ++k2) {
                bf16x8 a[2];
#pragma unroll
                for (int x = 0; x < 2; ++x) {
                    const bf16_t* pa = Ks + (32 * k2 + 8 * fq + (fr >> 2)) * 264 + 16 * (2 * wid + x) + 4 * (fr & 3);
                    const s16x4 lo = __builtin_amdgcn_ds_read_tr16_b64_v4i16((LAS s16x4*)pa), hi = __builtin_amdgcn_ds_read_tr16_b64_v4i16((LAS s16x4*)(pa + 4 * 264));
                    a[x] = __builtin_shufflevector(lo, hi, 0, 1, 2, 3, 4, 5, 6, 7);
                }
#pragma unroll
                for (int vi = 0; vi < 5; ++vi) {
                    const bf16x8 bv = *(const bf16x8*)(VW + (16 * vi + fr) * 72 + 32 * k2 + 8 * fq);
                    X[0][vi] = __builtin_amdgcn_mfma_f32_16x16x32_bf16(a[0], bv, X[0][vi], 0, 0, 0);
                    X[1][vi] = __builtin_amdgcn_mfma_f32_16x16x32_bf16(a[1], bv, X[1][vi], 0, 0, 0);
                }
            }
#pragma unroll
            for (int x = 0; x < 2; ++x)
#pragma unroll
                for (int vi = 0; vi < 5; ++vi) *(uint2*)(Cs + (16 * vi + fr) * 264 + 16 * (2 * wid + x) + 4 * fq) = pack4(X[x][vi][0], X[x][vi][1], X[x][vi][2], X[x][vi][3]);
        }
        if (cidx + 1 < 68 && wid == 0) scalars(cidx + 1, lane);
#ifndef EMU
        asm volatile("s_waitcnt vmcnt(0)" ::: "memory");
#endif
        __syncthreads();
        if (ck.sq) {
#pragma unroll
            for (int j = 0; j < 4; ++j) { const int t = 16 * ti + 4 * fq + j, pos = ck.P0 + (d ? 63 - t : t);
                bf16_t* hp = Hd + ((size_t)b * SEQ + pos) * DM + 256 * hd + 64 * vq + 32 * pr + fr;
                hp[0] = f2bf(hv0[j]); hp[16] = f2bf(hv1[j]); }
        }
    }
}
__device__ __forceinline__ void phase_mlstm_chunk(const Params& P, char* smem) {
    for (int item = blockIdx.x; item < 256; item += gridDim.x) {
        const int slot = item >> 3, chainid = (item & 7) * 8 + (slot >> 2), vq = slot & 3, d = chainid & 1, hd = (chainid >> 1) & 3, b = chainid >> 3;
        if (d) mlstm_item<1>(P, smem, vq, hd, b); else mlstm_item<0>(P, smem, vq, hd, b);
    }
}

constexpr int PRE_CWT = 0, PRE_QKV = 1024 * 8 * 4, PRE_LDS = PRE_QKV + 256 * 48 * 4;
__device__ __forceinline__ void phase_mlpre(const Params& P, char* smem) {
    const int tid = threadIdx.x, wid = tid >> 6, lane0 = tid & 63;
    float* cwt = (float*)(smem + PRE_CWT);
    float* qkv = (float*)(smem + PRE_QKV);
    __syncthreads();
    for (int i = tid; i < 1024 * 8; i += 512) { const int ch = i >> 3, e = i & 7; cwt[i] = e < 4 ? P.ml_conv_w[e * DM + ch] : (e == 4 ? P.ml_conv_b[ch] : 0.f); }
    for (int i = tid; i < 256 * 48; i += 512) { const int g = i / 48, e = i % 48, which = e >> 4, wi_ = g * 16 + (e & 15); qkv[i] = which == 0 ? P.ml_wq[wi_] : which == 1 ? P.ml_wk[wi_] * 0.0625f : P.ml_wv[wi_]; }
    __syncthreads();
    const bf16_t* WG = (const bf16_t*)(P.ws + OFF_WG);
    float* logi = (float*)(P.ws + OFF_LOGI); float* logf_ = (float*)(P.ws + OFF_LOGF);
    for (int tile = wid * gridDim.x + blockIdx.x; tile < NB * 272; tile += 8 * gridDim.x) {
        const int b = tile / 272, r = tile % 272, sq = r >= 16, pos0 = sq ? (r - 16) * 16 : r * 16, Ls = sq ? SEQ : CTXL, pidx0 = sq ? CTXL + pos0 : pos0;
        f32x4 acc = (f32x4){0.f, 0.f, 0.f, 0.f};
        const bf16_t* rowp[4]; bool ok[4];
        {
            const int pos = pos0 + (lane0 & 15);
#pragma unroll
            for (int j = 0; j < 4; ++j) { const int pp = pos + j - 2; ok[j] = pp >= 0 && pp < Ls; rowp[j] = ml_row(P, b, sq, ok[j] ? pp : pos); }
        }
        uint4 nxt[4];
#pragma unroll
        for (int j = 0; j < 4; ++j) { nxt[j] = *(const uint4*)(rowp[j] + 8 * (lane0 >> 4)); if (!ok[j]) nxt[j].x = nxt[j].y = nxt[j].z = nxt[j].w = 0u; }
        for (int ks = 0; ks < 32; ++ks) {
            int lane = lane0; LAUNDER(lane);
            const int fq = lane >> 4, c0 = 32 * ks + 8 * fq;
            uint4 cur[4];
#pragma unroll
            for (int j = 0; j < 4; ++j) cur[j] = nxt[j];
            if (ks + 1 < 32) {
#pragma unroll
                for (int j = 0; j < 4; ++j) { nxt[j] = *(const uint4*)(rowp[j] + 32 * (ks + 1) + 8 * fq); if (!ok[j]) nxt[j].x = nxt[j].y = nxt[j].z = nxt[j].w = 0u; }
            }
            float u[4][8];
#pragma unroll
            for (int j = 0; j < 4; ++j) { uint2 lo, hi; lo.x = cur[j].x; lo.y = cur[j].y; hi.x = cur[j].z; hi.y = cur[j].w; float a4[4], b4[4]; unpack4(lo, a4); unpack4(hi, b4);
#pragma unroll
                for (int c = 0; c < 4; ++c) { u[j][c] = a4[c]; u[j][4 + c] = b4[c]; } }
            float xm[8];
#pragma unroll
            for (int c = 0; c < 8; ++c) { const float4 w = *(const float4*)(cwt + (c0 + c) * 8); const float bb = cwt[(c0 + c) * 8 + 4];
                xm[c] = siluf_(bb + w.x * u[0][c] + w.y * u[1][c] + w.z * u[2][c] + w.w * u[3][c]); }
            { const uint2 a = pack4(xm[0], xm[1], xm[2], xm[3]), c = pack4(xm[4], xm[5], xm[6], xm[7]); uint4 px; px.x = a.x; px.y = a.y; px.z = c.x; px.w = c.y;
              *(uint4*)(xm_row(P, b, sq, pos0 + (lane & 15)) + c0) = px; }
            float q[8], k[8], v[8];
#pragma unroll
            for (int gi = 0; gi < 2; ++gi) { const float* wg = qkv + ((c0 >> 2) + gi) * 48;
#pragma unroll
                for (int o = 0; o < 4; ++o) {
                    q[4 * gi + o] = xm[4 * gi] * wg[o] + xm[4 * gi + 1] * wg[4 + o] + xm[4 * gi + 2] * wg[8 + o] + xm[4 * gi + 3] * wg[12 + o];
                    k[4 * gi + o] = xm[4 * gi] * wg[16 + o] + xm[4 * gi + 1] * wg[20 + o] + xm[4 * gi + 2] * wg[24 + o] + xm[4 * gi + 3] * wg[28 + o];
                    v[4 * gi + o] = u[2][4 * gi] * wg[32 + o] + u[2][4 * gi + 1] * wg[36 + o] + u[2][4 * gi + 2] * wg[40 + o] + u[2][4 * gi + 3] * wg[44 + o]; } }
            uint4 pq, pk, pv; { const uint2 a = pack4(q[0], q[1], q[2], q[3]), c = pack4(q[4], q[5], q[6], q[7]); pq.x = a.x; pq.y = a.y; pq.z = c.x; pq.w = c.y; }
            { const uint2 a = pack4(k[0], k[1], k[2], k[3]), c = pack4(k[4], k[5], k[6], k[7]); pk.x = a.x; pk.y = a.y; pk.z = c.x; pk.w = c.y; }
            { const uint2 a = pack4(v[0], v[1], v[2], v[3]), c = pack4(v[4], v[5], v[6], v[7]); pv.x = a.x; pv.y = a.y; pv.z = c.x; pv.w = c.y; }
            const bf16x8 bq = *(const bf16x8*)(WG + ((size_t)(0 * 32 + ks) * 64 + lane) * 8), bk = *(const bf16x8*)(WG + ((size_t)(1 * 32 + ks) * 64 + lane) * 8), bvv = *(const bf16x8*)(WG + ((size_t)(2 * 32 + ks) * 64 + lane) * 8);
            acc = __builtin_amdgcn_mfma_f32_16x16x32_bf16(__builtin_bit_cast(bf16x8, pq), bq, acc, 0, 0, 0);
            acc = __builtin_amdgcn_mfma_f32_16x16x32_bf16(__builtin_bit_cast(bf16x8, pk), bk, acc, 0, 0, 0);
            acc = __builtin_amdgcn_mfma_f32_16x16x32_bf16(__builtin_bit_cast(bf16x8, pv), bvv, acc, 0, 0, 0);
        }
        {
            const int fr = lane0 & 15, fq = lane0 >> 4, type = fr >> 3, dd = (fr >> 2) & 1, hh = fr & 3;
            const float bias = (type ? P.ml_bf : P.ml_bi)[dd * 4 + hh];
            float4 o; float* ov = (float*)&o;
#pragma unroll
            for (int j = 0; j < 4; ++j) { const float pre = acc[j] + bias; ov[j] = type ? -softplusf_(-pre) : pre; }
            *(float4*)((type ? logf_ : logi) + ((size_t)(b * 2 + dd) * 4 + hh) * LTOT + pidx0 + 4 * fq) = o;
        }
    }
    __syncthreads();
}

__device__ __forceinline__ void phase_yml(const Params& P) {
    const int lane = threadIdx.x & 63, gw = (blockIdx.x * blockDim.x + threadIdx.x) >> 6, nw = (gridDim.x * blockDim.x) >> 6;
    const bf16_t* hf = (const bf16_t*)(P.ws + OFF_RGX); const bf16_t* hb = (const bf16_t*)(P.ws + OFF_GGELU); const bf16_t* smlo = (const bf16_t*)(P.ws + OFF_SMLO);
    bf16_t* yml = (bf16_t*)P.out;
    for (int idx = gw; idx < NB * SEQ; idx += nw) {
        const int b = idx >> 12, p = idx & 4095, t = lat_tok(p);
        const size_t hrow = ((size_t)b * SEQ + p) * DM, orow = ((size_t)b * SEQ + t) * DM;
        uint2 outw[4];
#pragma unroll
        for (int i = 0; i < 4; ++i) {
            const int c0 = 256 * i + 4 * lane;
            float a[4], bb[4], hv[4];
            unpack4(*(const uint2*)(hf + hrow + c0), a); unpack4(*(const uint2*)(hb + hrow + c0), bb);
#pragma unroll
            for (int j = 0; j < 4; ++j) hv[j] = a[j] + bb[j];
            const float mu = wave_sum(hv[0] + hv[1] + hv[2] + hv[3]) * (1.0f / 256.0f);
            float dv[4], q = 0.f;
#pragma unroll
            for (int j = 0; j < 4; ++j) { dv[j] = hv[j] - mu; q += dv[j] * dv[j]; }
            const float rs = rsqrtf(wave_sum(q) * (1.0f / 256.0f) + EPS);
            float xmv[4]; unpack4(*(const uint2*)(xm_row(P, b, 1, p) + c0), xmv);
            float sg[4]; unpack4(*(const uint2*)(smlo + orow + c0), sg);
            float y[4];
#pragma unroll
            for (int j = 0; j < 4; ++j) y[j] = (dv[j] * rs * P.ml_norm_g[c0 + j] + P.ml_skip[c0 + j] * xmv[j]) * sg[j];
            outw[i] = pack4(y[0], y[1], y[2], y[3]);
        }
#pragma unroll
        for (int i = 0; i < 4; ++i) *(uint2*)(yml + orow + 256 * i + 4 * lane) = outw[i];
    }
}

#ifndef EMU
#define XB_TMO      128
#define XB_XCNT(j)  (256  + 64 * (j))
#define XB_XSUB(j)  (1280 + 64 * (j))
#define XB_XGEN(j)  (2304 + 64 * (j))
#define XB_TOP      3328
#define XB_TOPGEN   3392
#define XCD_BAR_WORDS 3456
#define XB_SPIN_CAP (1u << 18)
__device__ __forceinline__ unsigned xb_ld(unsigned* p)              { return __hip_atomic_load(p, __ATOMIC_RELAXED, __HIP_MEMORY_SCOPE_AGENT); }
__device__ __forceinline__ unsigned xb_add(unsigned* p, unsigned v) { return __hip_atomic_fetch_add(p, v, __ATOMIC_RELAXED, __HIP_MEMORY_SCOPE_AGENT); }
__device__ __forceinline__ unsigned xb_xcc_id() { return (unsigned)__builtin_amdgcn_s_getreg((3 << 11) | 20) & 0xFu; }
#define XB_SPIN(cond, bar) do { unsigned _sp = 0; while (cond) { __builtin_amdgcn_s_sleep(1); \
    if ((++_sp & 255u) == 0u) { if (xb_ld(&(bar)[XB_TMO])) break; if (_sp > XB_SPIN_CAP) { atomicAdd(&(bar)[XB_TMO], 1u); break; } } } } while (0)
struct XcdBarrier { unsigned* bar; unsigned x; volatile LAS unsigned* st; };
__device__ __forceinline__ XcdBarrier xcd_barrier_post(unsigned* bar, volatile LAS unsigned* st) {
    XcdBarrier b; b.bar = bar; b.x = xb_xcc_id(); b.st = st;
    if (threadIdx.x == 0) (void)xb_add(&bar[XB_XCNT(b.x)], 1u);
    return b;
}
__device__ __forceinline__ void xcd_barrier_complete(unsigned* bar, unsigned x, unsigned& nloc, unsigned& nx) {
    const unsigned G = gridDim.x * gridDim.y * gridDim.z;
    unsigned sum, cnt, mine, sp = 0u;
    for (;;) {
        sum = 0u; cnt = 0u; mine = 0u;
#pragma unroll
        for (unsigned j = 0; j < 16; ++j) { const unsigned c = xb_ld(&bar[XB_XCNT(j)]); sum += c; cnt += (c > 0u) ? 1u : 0u; mine = (j == x) ? c : mine; }
        if (sum == G) break;
        __builtin_amdgcn_s_sleep(1);
        if ((++sp & 255u) == 0u) { if (xb_ld(&bar[XB_TMO])) break; if (sp > XB_SPIN_CAP) { atomicAdd(&bar[XB_TMO], 1u); break; } }
    }
    nloc = mine > 0u ? mine : 1u; nx = cnt > 0u ? cnt : 1u;
}
__device__ __forceinline__ void xcd_barrier(const XcdBarrier& b) {
    asm volatile("s_waitcnt vmcnt(0)" ::: "memory");
    __syncthreads();
    if (threadIdx.x == 0) {
        unsigned* bar = b.bar;
        __builtin_amdgcn_s_waitcnt(0);
        unsigned nloc = b.st[0], nx = b.st[1];
        if (nloc == 0u) { xcd_barrier_complete(bar, b.x, nloc, nx); b.st[0] = nloc; b.st[1] = nx; }
        const unsigned old = xb_add(&bar[XB_XSUB(b.x)], 1u);
        const unsigned gen = old / nloc;
        if (old + 1u == (gen + 1u) * nloc) {
            __builtin_amdgcn_fence(__ATOMIC_RELEASE, "agent");
            asm volatile("s_waitcnt vmcnt(0)" ::: "memory");
            const unsigned og = xb_add(&bar[XB_TOP], 1u);
            const unsigned tg = og / nx;
            if (og + 1u == (tg + 1u) * nx) xb_add(&bar[XB_TOPGEN], 1u);
            else XB_SPIN(xb_ld(&bar[XB_TOPGEN]) == tg, bar);
            __builtin_amdgcn_fence(__ATOMIC_ACQUIRE, "agent");
            xb_add(&bar[XB_XGEN(b.x)], 1u);
            asm volatile("s_waitcnt vmcnt(0)" ::: "memory");
        } else {
            XB_SPIN(xb_ld(&bar[XB_XGEN(b.x)]) == gen, bar);
            __builtin_amdgcn_fence(__ATOMIC_ACQUIRE, "agent");
            asm volatile("s_waitcnt vmcnt(0)" ::: "memory");
        }
    }
    __syncthreads();
}

static_assert(PRE_LDS <= ML_LDS && RG_LDS <= ML_LDS, "LDS");
constexpr int SMEM_BYTES = ML_LDS > GEMM_LDS ? ML_LDS : GEMM_LDS;
__global__ void __launch_bounds__(512) fwd_mega(Params P) {
    extern __shared__ __attribute__((aligned(16))) unsigned char dyn_lds[];
    char* smem = (char*)dyn_lds;
    LAS unsigned char* lds = (LAS unsigned char*)dyn_lds;
    cg::grid_group grid = cg::this_grid();
    char* ws = P.ws;
    const int G = gridDim.x, c = blockIdx.x;
    const float* modl = (const float*)(ws + OFF_MODL);
    volatile LAS unsigned* xst = (volatile LAS unsigned*)(lds + SMEM_BYTES);
    if (threadIdx.x == 0) { xst[0] = 0u; xst[1] = 0u; }
    __syncthreads();
    const XcdBarrier xb = xcd_barrier_post((unsigned*)(ws + OFF_BAR), xst);
    phase_prep(P, smem);
    grid.sync();
    phase_u(P);
    xcd_barrier(xb);
    { SchedInProj s{ws + OFF_U, ws + OFF_UC, ws + OFF_WINT, G, c}; EpiInProj e{(bf16_t*)(ws + OFF_RGX), (bf16_t*)(ws + OFF_RGXC), (bf16_t*)(ws + OFF_MLXC)}; gemm8(lds, DM, s, e); }
    xcd_barrier(xb);
    phase_rg(P, smem);
    phase_mlpre(P, smem);
    xcd_barrier(xb);
    phase_mlstm_chunk(P, smem);
    xcd_barrier(xb);
    phase_yml(P);
    xcd_barrier(xb);
    { SchedBranch s{ws + OFF_U, ws + OFF_WBRG, (const char*)P.out, ws + OFF_WBML, G, c}; EpiBranch e{(const bf16_t*)(ws + OFF_SGR), (const bf16_t*)(ws + OFF_SGM), (bf16_t*)(ws + OFF_MLX)}; gemm8(lds, DM, s, e); }
    xcd_barrier(xb);
    { SchedPlain s{ws + OFF_MLX, ws + OFF_WOUT, 128, 4, G, c, TSTEP1024}; EpiOutProj e{P.x, modl, P.out}; gemm8(lds, DM, s, e); }
    xcd_barrier(xb);
    phase_h2(P);
    xcd_barrier(xb);
    { SchedPlain s{ws + OFF_U, ws + OFF_FFNIN, 128, 22, G, c, TSTEP1024}; EpiFfnIn e{(bf16_t*)(ws + OFF_RGX)}; gemm8(lds, DM, s, e); }
    xcd_barrier(xb);
    { SchedPlain s{ws + OFF_RGX, ws + OFF_FFNOUT, 128, 4, G, c, TSTEP_FF}; EpiFfnOut e{P.out, modl}; gemm8(lds, DFF, s, e); }
    xcd_barrier(xb);
    phase_final(P);
}

extern "C" void kernel_launch(void* const* d_in, const int* in_sizes, int n_in, void* d_out, int out_size, void* d_ws, size_t ws_size, hipStream_t stream) {
    (void)in_sizes; (void)n_in; (void)out_size;
    if (ws_size < WS_TOTAL) { fprintf(stderr, "workspace too small: %zu < %zu\n", ws_size, (size_t)WS_TOTAL); return; }
    static int grid_blocks = 0;
    if (!grid_blocks) {
        int dev = 0, cus = 0, per_cu = 0;
        (void)hipGetDevice(&dev);
        (void)hipDeviceGetAttribute(&cus, hipDeviceAttributeMultiprocessorCount, dev);
        if (hipFuncSetAttribute((const void*)fwd_mega, hipFuncAttributeMaxDynamicSharedMemorySize, SMEM_BYTES + 16) != hipSuccess) fprintf(stderr, "hipFuncSetAttribute failed\n");
        (void)hipOccupancyMaxActiveBlocksPerMultiprocessor(&per_cu, fwd_mega, 512, SMEM_BYTES + 16);
        if (per_cu < 1) fprintf(stderr, "occupancy query reports %d blocks per CU\n", per_cu);
        grid_blocks = cus;
    }
    Params P{};
    const float** pp = (const float**)&P;
    for (int i = 0; i < 33; ++i) pp[i] = (const float*)d_in[i];
    P.out = (float*)d_out; P.ws = (char*)d_ws;
    if (hipMemsetAsync((char*)d_ws + OFF_BAR, 0, XCD_BAR_WORDS * 4, stream) != hipSuccess) fprintf(stderr, "memset of barrier words failed\n");
    void* args[] = {&P};
    hipError_t e = hipLaunchCooperativeKernel((void*)fwd_mega, dim3(grid_blocks), dim3(512), args, SMEM_BYTES + 16, stream);
    if (e != hipSuccess) fprintf(stderr, "cooperative launch failed: %s (grid %d)\n", hipGetErrorString(e), grid_blocks);
}
#endif
```
